# Optimizing an MI355X kernel written in HIP

```python
import jax, jax.numpy as jnp
from jax import lax
import numpy as np

D_MODEL = 2048
BATCH = 4
SEQ = 2048
DEPTH = 1

N_ATTN_HEADS = 8
HEAD_DIM = 128
ATTN_WIDTH = N_ATTN_HEADS * HEAD_DIM
POOL_WIDTH = D_MODEL - ATTN_WIDTH
POOL_WINDOWS = (2, 4, 8, 16)
N_POOL_GROUPS = len(POOL_WINDOWS)
POOL_GROUP_WIDTH = POOL_WIDTH // N_POOL_GROUPS
IN_WIDTH = 3 * ATTN_WIDTH + POOL_WIDTH
MOBA_BLOCK = 256
MOBA_TOPK = 3
Q_CHUNK = 32
ROPE_THETA = 10000.0
D_FF = -(-8 * D_MODEL // (3 * 256)) * 256
N_MOD = 6
EPS = 1e-6

kernel_name = "hymba_moba_pool_hybrid_layer"


def rmsnorm(x, g):
    xf = x.astype(jnp.float32)
    y = xf * lax.rsqrt(jnp.mean(xf * xf, axis=-1, keepdims=True) + EPS)
    return (y * g.astype(jnp.float32)).astype(x.dtype)


def rope(x, positions):
    dh = x.shape[-1]
    inv_freq = ROPE_THETA ** (-jnp.arange(0, dh, 2, dtype=jnp.float32) / dh)
    ang = positions[:, None, :, None].astype(jnp.float32) * inv_freq
    cos, sin = jnp.cos(ang), jnp.sin(ang)
    xf = x.astype(jnp.float32)
    x1, x2 = xf[..., : dh // 2], xf[..., dh // 2:]
    out = jnp.concatenate([x1 * cos - x2 * sin, x2 * cos + x1 * sin], axis=-1)
    return out.astype(x.dtype)


def moba_attention(q, k, v):
    B, H, S, Dh = q.shape
    nb = -(-S // MOBA_BLOCK)
    pad = nb * MOBA_BLOCK - S
    kb = jnp.pad(k, ((0, 0), (0, 0), (0, pad), (0, 0))).reshape(B, H, nb, MOBA_BLOCK, Dh)
    vb = jnp.pad(v, ((0, 0), (0, 0), (0, pad), (0, 0))).reshape(B, H, nb, MOBA_BLOCK, Dh)
    kmean = jnp.mean(kb.astype(jnp.float32), axis=3)
    kk = min(MOBA_TOPK, nb)
    scale = Dh ** -0.5
    bi = jnp.arange(B)[:, None, None, None]
    hi = jnp.arange(H)[None, :, None, None]
    blk_ids = jnp.arange(nb)

    def chunk(ci):
        start = ci * Q_CHUNK
        qc = lax.dynamic_slice_in_dim(q, start, Q_CHUNK, axis=2)
        t = start + jnp.arange(Q_CHUNK)
        own = start // MOBA_BLOCK
        gate = jnp.einsum('bhqd,bhnd->bhqn', qc.astype(jnp.float32), kmean)
        gate = jnp.where(blk_ids < own, gate, -jnp.inf)
        _, idx = lax.top_k(gate, kk)
        valid = idx < own
        ksel = kb[bi, hi, idx]
        vsel = vb[bi, hi, idx]
        s_sel = jnp.einsum('bhqd,bhqkjd->bhqkj', qc, ksel).astype(jnp.float32) * scale
        s_sel = jnp.where(valid[..., None], s_sel, -jnp.inf).reshape(B, H, Q_CHUNK, kk * MOBA_BLOCK)
        kown = lax.dynamic_index_in_dim(kb, own, axis=2, keepdims=False)
        vown = lax.dynamic_index_in_dim(vb, own, axis=2, keepdims=False)
        s_own = jnp.einsum('bhqd,bhjd->bhqj', qc, kown).astype(jnp.float32) * scale
        kpos = own * MOBA_BLOCK + jnp.arange(MOBA_BLOCK)
        s_own = jnp.where(kpos[None, :] <= t[:, None], s_own, -jnp.inf)
        p = jax.nn.softmax(jnp.concatenate([s_sel, s_own], axis=-1), axis=-1)
        p_sel = p[..., : kk * MOBA_BLOCK].reshape(B, H, Q_CHUNK, kk, MOBA_BLOCK).astype(v.dtype)
        p_own = p[..., kk * MOBA_BLOCK:].astype(v.dtype)
        return (jnp.einsum('bhqkj,bhqkjd->bhqd', p_sel, vsel)
                + jnp.einsum('bhqj,bhjd->bhqd', p_own, vown))

    out = lax.map(chunk, jnp.arange(S // Q_CHUNK))
    return out.transpose(1, 2, 0, 3, 4).reshape(B, H, S, Dh)


def pool_mixer(u, w_pool, pool_scale):
    B, S, _ = u.shape
    uf = u.astype(jnp.float32)
    cs = jnp.pad(jnp.cumsum(uf, axis=1), ((0, 0), (1, 0), (0, 0)))
    t = jnp.arange(S)
    outs = []
    for g, w in enumerate(POOL_WINDOWS):
        sl = slice(g * POOL_GROUP_WIDTH, (g + 1) * POOL_GROUP_WIDTH)
        lo = jnp.maximum(t + 1 - w, 0)
        win_sum = cs[:, 1:, sl] - cs[:, lo, sl]
        cnt = (t + 1 - lo).astype(jnp.float32)
        pooled = (win_sum / cnt[None, :, None] - uf[..., sl]).astype(u.dtype)
        outs.append(jnp.einsum('bsc,cd->bsd', pooled, w_pool[g]))
    return jnp.concatenate(outs, axis=-1) * pool_scale


def setup_inputs(seed: int = 0) -> dict:
    key = jax.random.key(seed)
    ks = jax.random.split(key, 18)
    f32 = jnp.float32
    nrm = lambda k, shape, s: jax.random.normal(k, shape, f32) * s
    x = jax.random.normal(ks[0], (BATCH, SEQ, D_MODEL), f32)
    c = jax.random.normal(ks[1], (BATCH, D_MODEL), f32)
    offs = jax.random.randint(ks[2], (BATCH, 1), 0, 1024, dtype=jnp.int32)
    positions = offs + jnp.arange(SEQ, dtype=jnp.int32)[None, :]
    return {
        "x": x,
        "c": c,
        "positions": positions,
        "w_ada": nrm(ks[3], (DEPTH, D_MODEL, N_MOD * D_MODEL), 0.5 * D_MODEL ** -0.5),
        "b_ada": nrm(ks[4], (DEPTH, N_MOD * D_MODEL), 0.02),
        "g_mix_norm": 1.0 + nrm(ks[5], (DEPTH, D_MODEL), 0.02),
        "w_in": nrm(ks[6], (DEPTH, D_MODEL, IN_WIDTH), D_MODEL ** -0.5),
        "g_q": 1.0 + nrm(ks[7], (DEPTH, HEAD_DIM), 0.02),
        "g_k": 1.0 + nrm(ks[8], (DEPTH, HEAD_DIM), 0.02),
        "w_pool": nrm(ks[9], (DEPTH, N_POOL_GROUPS, POOL_GROUP_WIDTH, POOL_GROUP_WIDTH), POOL_GROUP_WIDTH ** -0.5),
        "pool_scale": 1.0 + nrm(ks[10], (DEPTH, POOL_WIDTH), 0.1),
        "w_out": nrm(ks[11], (DEPTH, D_MODEL, D_MODEL), D_MODEL ** -0.5),
        "g_ffn_norm": 1.0 + nrm(ks[12], (DEPTH, D_MODEL), 0.02),
        "w_gate": nrm(ks[13], (DEPTH, D_MODEL, D_FF), D_MODEL ** -0.5),
        "w_up": nrm(ks[14], (DEPTH, D_MODEL, D_FF), D_MODEL ** -0.5),
        "w_down": nrm(ks[15], (DEPTH, D_FF, D_MODEL), D_FF ** -0.5),
    }


def reference(x, c, positions, w_ada, b_ada, g_mix_norm, w_in, g_q, g_k, w_pool,
              pool_scale, w_out, g_ffn_norm, w_gate, w_up, w_down):
    B, S, D = x.shape
    for l in range(DEPTH):
        mod = jnp.einsum('bd,de->be', jax.nn.silu(c), w_ada[l]) + b_ada[l]
        sh1, sc1, gt1, sh2, sc2, gt2 = [m[:, None, :] for m in jnp.split(mod, N_MOD, axis=-1)]

        h = rmsnorm(x, g_mix_norm[l]) * (1.0 + sc1) + sh1
        z = jnp.einsum('bsd,de->bse', h, w_in[l])
        q, k, v, u = jnp.split(z, [ATTN_WIDTH, 2 * ATTN_WIDTH, 3 * ATTN_WIDTH], axis=-1)
        to_heads = lambda a: a.reshape(B, S, N_ATTN_HEADS, HEAD_DIM)
        q = rope(rmsnorm(to_heads(q), g_q[l]).transpose(0, 2, 1, 3), positions)
        k = rope(rmsnorm(to_heads(k), g_k[l]).transpose(0, 2, 1, 3), positions)
        v = to_heads(v).transpose(0, 2, 1, 3)
        o_attn = moba_attention(q, k, v).transpose(0, 2, 1, 3).reshape(B, S, ATTN_WIDTH)
        o_pool = pool_mixer(u, w_pool[l], pool_scale[l])
        y = jnp.einsum('bse,ed->bsd', jnp.concatenate([o_attn, o_pool], axis=-1), w_out[l])
        x = x + gt1 * y

        h2 = rmsnorm(x, g_ffn_norm[l]) * (1.0 + sc2) + sh2
        a = jnp.einsum('bsd,df->bsf', h2, w_gate[l])
        b = jnp.einsum('bsd,df->bsf', h2, w_up[l])
        f = jnp.einsum('bsf,fd->bsd', jax.nn.silu(a) * b, w_down[l])
        x = x + gt2 * f
    return x
```

```cpp
#include <hip/hip_runtime.h>
#include <hip/hip_cooperative_groups.h>
#include <cstdio>
#include <cstdint>
#include <cmath>
namespace cg = cooperative_groups;

#define LAS __attribute__((address_space(3)))
typedef unsigned short bf16_t;
typedef short bf16x8 __attribute__((ext_vector_type(8)));
typedef short s16x4 __attribute__((ext_vector_type(4)));
typedef float f32x4 __attribute__((ext_vector_type(4)));
typedef float f32x2 __attribute__((ext_vector_type(2)));
typedef unsigned u32x4 __attribute__((ext_vector_type(4)));
typedef unsigned u32x2 __attribute__((ext_vector_type(2)));

constexpr int DM = 2048, NB = 4, SEQ = 2048, MTOK = NB * SEQ;
constexpr int NH = 8, HD = 128, AW = 1024, PW = 1024, INW = 4096, DFF = 5632, NMOD = 6, MODW = NMOD * DM;
constexpr int MBLK = 256, NBLK = SEQ / MBLK;
constexpr float EPS = 1e-6f;
constexpr int NTHR = 512, NWAVES = 8;

constexpr size_t MiB = 1u << 20;
constexpr size_t WS_CTL = 0, CTL_ZERO_BYTES = 65536;
constexpr size_t WS_SLOTS = 512 * 1024;
constexpr int CW_PANEL = 4096;
constexpr size_t WS_PART = 1 * MiB;
constexpr size_t WS_MOD = 2 * MiB;
constexpr size_t WS_KMEAN = 3 * MiB;
constexpr size_t WS_WIN = 4 * MiB;
constexpr size_t WS_WOUT = 20 * MiB;
constexpr size_t WS_WGU = 28 * MiB;
constexpr size_t WS_WDN = 72 * MiB;
constexpr size_t WS_WPOOL = 94 * MiB;
constexpr size_t WS_XN = 96 * MiB;
constexpr size_t WS_ZF = 128 * MiB;
constexpr size_t WS_Q = 256 * MiB;
constexpr size_t WS_K = 272 * MiB;
constexpr size_t WS_VT = 288 * MiB;
constexpr size_t WS_PB = 304 * MiB;
constexpr size_t WS_OC = 320 * MiB;
constexpr size_t WS_COS = 352 * MiB;
constexpr size_t WS_SIN = 354 * MiB;
constexpr size_t WS_END = 356 * MiB;

constexpr int LDS_BYTES = 147456;

__device__ __forceinline__ unsigned f2bf(float f) { unsigned u = __builtin_bit_cast(unsigned, f); return (u + 0x7fffu + ((u >> 16) & 1u)) >> 16; }
typedef __bf16 bf16x2_hw __attribute__((ext_vector_type(2)));
__device__ __forceinline__ unsigned pk2(float lo, float hi) { f32x2 v = {lo, hi}; bf16x2_hw b = __builtin_convertvector(v, bf16x2_hw); return __builtin_bit_cast(unsigned, b); }
__device__ __forceinline__ float bf2f(unsigned short h) { return __builtin_bit_cast(float, (unsigned)h << 16); }
template <int M> __device__ __forceinline__ float swz_xor(float v) { return __builtin_bit_cast(float, __builtin_amdgcn_ds_swizzle(__builtin_bit_cast(int, v), (M << 10) | 0x1f)); }
__device__ __forceinline__ float get_x32(float v, int lane) { return __builtin_bit_cast(float, __builtin_amdgcn_ds_bpermute((lane ^ 32) << 2, __builtin_bit_cast(int, v))); }
__device__ __forceinline__ float add_x32(float v, int lane) { return v + get_x32(v, lane); }
__device__ __forceinline__ float max_x32(float v, int lane) { return fmaxf(v, get_x32(v, lane)); }
__device__ __forceinline__ float wave_sum(float v, int lane) {
    v += swz_xor<1>(v); v += swz_xor<2>(v); v += swz_xor<4>(v); v += swz_xor<8>(v); v += swz_xor<16>(v);
    return add_x32(v, lane);
}
__device__ __forceinline__ int tid_fresh() { int t = threadIdx.x; asm volatile("" : "+v"(t)); return t; }
__device__ __forceinline__ float max3f(float a, float b, float c) { float r; asm("v_max3_f32 %0, %1, %2, %3" : "=v"(r) : "v"(a), "v"(b), "v"(c)); return r; }
__device__ __forceinline__ float silu_f(float v) { return v / (1.0f + __expf(-v)); }

namespace pg8 {
constexpr int BM = 256, BK = 64, HALF = 128, HTB = HALF * BK * 2, STAGE_BYTES = 8 * HTB, NXCD = 8, WGM = 8;
__host__ __device__ __forceinline__ int lds_byte(int r, int c) { const int st = (r >> 4) * 2 + (c >> 5), rr = r & 15, cc = c & 31, ob = rr * 64 + cc * 2; return st * 1024 + (ob ^ (((ob >> 9) & 1) << 5)); }
__host__ __device__ __forceinline__ void stage_rc(int b, int& R, int& C) { const int st = b / 1024, sb = b % 1024, swz = sb ^ (((sb >> 9) & 1) << 5); R = (st >> 1) * 16 + swz / 64; C = (st & 1) * 32 + (swz % 64) / 2; }

struct Unit { int pm, pn; };
struct Gemm { const bf16_t* A; const bf16_t* Bt; int M, N, K, lda, ldb; };

struct StaticOrder {
    int nM, nN, nwg, G, c, lim;
    __device__ void init(int M, int N, int G_, int c_) { nM = M / BM; nN = N / BM; nwg = nM * nN; G = G_; c = c_; lim = nwg; }
    __device__ bool at(int L, Unit& u) const { return deal((long)L, u); }
    __device__ bool next(int i, Unit& u) const { const long L = (long)i * G + c; if (L >= lim) return false; return deal(L, u); }
    __device__ bool deal(long L, Unit& u) const {
        if (L >= nwg) return false;
        int wgid = (int)L; { const int q = nwg / NXCD, r = nwg % NXCD, xcd = wgid % NXCD, off = wgid / NXCD; wgid = (xcd < r ? xcd * (q + 1) : r * (q + 1) + (xcd - r) * q) + off; }
        const int nig = WGM * nN, gid = wgid / nig, fm = gid * WGM, gsz = (nM - fm) < WGM ? (nM - fm) : WGM;
        u.pm = fm + ((wgid % nig) % gsz); u.pn = (wgid % nig) / gsz; return true;
    }
};
struct OneUnit {
    int pm, pn, has;
    __device__ bool next(int i, Unit& u) const { if (i > 0 || !has) return false; u.pm = pm; u.pn = pn; return true; }
};

template <class Epi, class Sched, bool ALIGN_EPI, int NB = 2>
__device__ __forceinline__ void gemm_phase(LAS unsigned char* lds, const Gemm g, const Sched& S, const Epi& E) {
    const int tid = tid_fresh(), wid = __builtin_amdgcn_readfirstlane(tid >> 6), lane = tid & 63, wr = wid >> 2, wc = wid & 3, fr = lane & 15, fq = lane >> 4;
    const int K = g.K, nt = K / BK;
    unsigned voffA[2], voffB[2];
#pragma unroll
    for (int i = 0; i < 2; ++i) { int R, C; stage_rc(tid * 16 + i * 8192, R, C);
        voffA[i] = (unsigned)(R * g.lda + C) * 2u; voffB[i] = (unsigned)(R * g.ldb + C) * 2u; }
    const size_t kstep = (size_t)(BK * 2);
    const size_t hstepA = (size_t)HALF * g.lda * 2, hstepB = (size_t)HALF * g.ldb * 2;
    const size_t tstepA = 2 * hstepA, tstepB = 2 * hstepB;
    const unsigned ldsw = (unsigned)wid * 1024u;
    const int aoff = lds_byte(wr * 64 + fr, fq * 8), boff = lds_byte(wc * 32 + fr, fq * 8);
#define PG8_SA(b, h) (((b) * 2 + (h)) * HTB)
#define PG8_SB(b, h) ((4 + (b) * 2 + (h)) * HTB)
#define PG8_STAGE(bufoff, gbase, voff) do { _Pragma("unroll") for (int _i = 0; _i < 2; ++_i) \
        __builtin_amdgcn_global_load_lds((const unsigned*)((const char*)(gbase) + (voff)[_i]), (LAS unsigned*)(lds + (bufoff) + ldsw + _i * 8192), 16, 0, 0); } while (0)
#define PG8_LDA(dst, b, h) do { _Pragma("unroll") for (int m = 0; m < 4; ++m) _Pragma("unroll") for (int k = 0; k < 2; ++k) dst[m][k] = *(const LAS bf16x8*)(lds + PG8_SA(b, h) + aoff + m * 2048 + k * 1024); } while (0)
#define PG8_LDB(dst, b, h) do { _Pragma("unroll") for (int n = 0; n < 2; ++n) _Pragma("unroll") for (int k = 0; k < 2; ++k) dst[n][k] = *(const LAS bf16x8*)(lds + PG8_SB(b, h) + boff + n * 2048 + k * 1024); } while (0)
#define PG8_MMA(ai, bj, At, Bt) do { __builtin_amdgcn_s_setprio(1); _Pragma("unroll") for (int m = 0; m < 4; ++m) _Pragma("unroll") for (int n = 0; n < 2; ++n) _Pragma("unroll") for (int k = 0; k < 2; ++k) \
        acc[ai][bj][m][n] = __builtin_amdgcn_mfma_f32_16x16x32_bf16(Bt[n][k], At[m][k], acc[ai][bj][m][n], 0, 0, 0); __builtin_amdgcn_s_setprio(0); } while (0)
#define PG8_WAIT_V(n) asm volatile("s_waitcnt vmcnt(" #n ")" ::: "memory")
#define PG8_WAIT_L(n) asm volatile("s_waitcnt lgkmcnt(" #n ")" ::: "memory")
#define PG8_BAR __builtin_amdgcn_s_barrier()
#define PG8_SCHED __builtin_amdgcn_sched_barrier(0)
    Unit cur, nxt; int ui = 0;
    if (!S.next(0, cur)) return;
    f32x4 acc[2][2][4][2];
#pragma unroll
    for (int a = 0; a < 2; ++a)
#pragma unroll
        for (int b = 0; b < 2; ++b)
#pragma unroll
            for (int m = 0; m < 4; ++m)
#pragma unroll
                for (int n = 0; n < 2; ++n) acc[a][b][m][n] = (f32x4){0.f, 0.f, 0.f, 0.f};
    bf16x8 At[4][2], B0[2][2], B1[2][2];
    const char* cA = (const char*)g.A + (size_t)cur.pm * tstepA; const char* cB = (const char*)g.Bt + (size_t)cur.pn * tstepB;
    constexpr bool FULL = (NB == 2); constexpr int BJ = FULL ? 0 : NB;
    if constexpr (FULL) {
    PG8_STAGE(PG8_SB(0, 0), cB, voffB); PG8_STAGE(PG8_SB(0, 1), cB + hstepB, voffB); PG8_STAGE(PG8_SA(0, 0), cA, voffA); PG8_STAGE(PG8_SA(0, 1), cA + hstepA, voffA);
    if (wr == 1) PG8_BAR;
    PG8_WAIT_V(2); PG8_BAR;
    PG8_STAGE(PG8_SB(1, 0), cB + kstep, voffB); PG8_STAGE(PG8_SA(1, 0), cA + kstep, voffA); PG8_STAGE(PG8_SB(1, 1), cB + hstepB + kstep, voffB);
    PG8_WAIT_V(6); PG8_BAR;
    } else {
    PG8_STAGE(PG8_SB(0, BJ), cB + BJ * hstepB, voffB); PG8_STAGE(PG8_SA(0, 0), cA, voffA); PG8_STAGE(PG8_SA(0, 1), cA + hstepA, voffA);
    if (wr == 1) PG8_BAR;
    PG8_WAIT_V(2); PG8_BAR;
    PG8_STAGE(PG8_SB(1, BJ), cB + BJ * hstepB + kstep, voffB); PG8_STAGE(PG8_SA(1, 0), cA + kstep, voffA);
    PG8_WAIT_V(4); PG8_BAR;
    }
    for (;;) {
        const bool has_next = S.next(ui + 1, nxt);
        const char* nA = has_next ? (const char*)g.A + (size_t)nxt.pm * tstepA : cA; const char* nB = has_next ? (const char*)g.Bt + (size_t)nxt.pn * tstepB : cB;
        for (int t = 0; t < nt; t += 2) {
            const bool last = (t == nt - 2);
            const char* a1 = cA + (size_t)(t + 1) * kstep;
            const char* a2 = last ? nA : cA + (size_t)(t + 2) * kstep; const char* b2 = last ? nB : cB + (size_t)(t + 2) * kstep;
            const char* a3 = a2 + kstep; const char* b3 = b2 + kstep;
            if constexpr (FULL) {
            PG8_LDB(B0, 0, 0); PG8_LDB(B1, 0, 1); PG8_SCHED; PG8_LDA(At, 0, 0); PG8_STAGE(PG8_SA(1, 1), a1 + hstepA, voffA);
            PG8_WAIT_V(8); PG8_WAIT_L(0); PG8_BAR; PG8_MMA(0, 0, At, B0); PG8_MMA(0, 1, At, B1); PG8_BAR; PG8_SCHED;
            PG8_LDA(At, 0, 1); PG8_STAGE(PG8_SB(0, 0), b2, voffB); PG8_STAGE(PG8_SB(0, 1), b2 + hstepB, voffB); PG8_STAGE(PG8_SA(0, 0), a2, voffA);
            PG8_WAIT_V(8); PG8_WAIT_L(0); PG8_BAR; PG8_MMA(1, 0, At, B0); PG8_MMA(1, 1, At, B1); PG8_BAR; PG8_SCHED;
            PG8_LDB(B0, 1, 0); PG8_LDB(B1, 1, 1); PG8_SCHED; PG8_LDA(At, 1, 0); PG8_STAGE(PG8_SA(0, 1), a2 + hstepA, voffA);
            PG8_WAIT_V(8); PG8_WAIT_L(0); PG8_BAR; PG8_MMA(0, 0, At, B0); PG8_MMA(0, 1, At, B1); PG8_BAR; PG8_SCHED;
            PG8_LDA(At, 1, 1); PG8_STAGE(PG8_SB(1, 0), b3, voffB); PG8_STAGE(PG8_SB(1, 1), b3 + hstepB, voffB); PG8_STAGE(PG8_SA(1, 0), a3, voffA);
            PG8_WAIT_V(8); PG8_WAIT_L(0); PG8_BAR; PG8_MMA(1, 0, At, B0); PG8_MMA(1, 1, At, B1); PG8_BAR; PG8_SCHED;
            } else {
            PG8_LDB(B0, 0, BJ); PG8_SCHED; PG8_LDA(At, 0, 0); PG8_STAGE(PG8_SA(1, 1), a1 + hstepA, voffA);
            PG8_WAIT_V(6); PG8_WAIT_L(0); PG8_BAR; PG8_MMA(0, BJ, At, B0); PG8_BAR; PG8_SCHED;
            PG8_LDA(At, 0, 1); PG8_STAGE(PG8_SB(0, BJ), b2 + BJ * hstepB, voffB); PG8_STAGE(PG8_SA(0, 0), a2, voffA);
            PG8_WAIT_V(6); PG8_WAIT_L(0); PG8_BAR; PG8_MMA(1, BJ, At, B0); PG8_BAR; PG8_SCHED;
            PG8_LDB(B0, 1, BJ); PG8_SCHED; PG8_LDA(At, 1, 0); PG8_STAGE(PG8_SA(0, 1), a2 + hstepA, voffA);
            PG8_WAIT_V(6); PG8_WAIT_L(0); PG8_BAR; PG8_MMA(0, BJ, At, B0); PG8_BAR; PG8_SCHED;
            PG8_LDA(At, 1, 1); PG8_STAGE(PG8_SB(1, BJ), b3 + BJ * hstepB, voffB); PG8_STAGE(PG8_SA(1, 0), a3, voffA);
            PG8_WAIT_V(6); PG8_WAIT_L(0); PG8_BAR; PG8_MMA(1, BJ, At, B0); PG8_BAR; PG8_SCHED;
            }
        }
        if constexpr (ALIGN_EPI) { if (wr == 0) PG8_BAR; }
        if constexpr (!Epi::AFTER_DRAIN) E(acc, cur, wr, wc, fr, fq);
        if (!has_next) break;
#pragma unroll
        for (int a = 0; a < 2; ++a)
#pragma unroll
            for (int b = 0; b < 2; ++b)
#pragma unroll
                for (int m = 0; m < 4; ++m)
#pragma unroll
                    for (int n = 0; n < 2; ++n) acc[a][b][m][n] = (f32x4){0.f, 0.f, 0.f, 0.f};
        cur = nxt; cA = nA; cB = nB; ++ui;
        if constexpr (ALIGN_EPI) { if (wr == 1) PG8_BAR; }
    }
    PG8_WAIT_V(0);
    if constexpr (!ALIGN_EPI) { if (wr == 0) PG8_BAR; }
    PG8_BAR;
    if constexpr (Epi::AFTER_DRAIN) E.fused(acc, cur, wr, wc, fr, fq, lds, wid, lane);
#undef PG8_SA
#undef PG8_SB
#undef PG8_STAGE
#undef PG8_LDA
#undef PG8_LDB
#undef PG8_MMA
#undef PG8_WAIT_V
#undef PG8_WAIT_L
#undef PG8_BAR
#undef PG8_SCHED
}

struct EpiF32 {
    static constexpr bool AFTER_DRAIN = false;
    bf16_t* Z; int ldc; bf16_t* V; bf16_t* Q; bf16_t* K; float* kmean; const float* gq; const float* gk; const float* cosT; const float* sinT; LAS float* xl;
    __device__ __forceinline__ void operator()(const f32x4 (&acc)[2][2][4][2], const Unit& uu, int wr, int wc, int fr_in, int fq_in) const {
        int fr = fr_in, fq = fq_in; asm volatile("" : "+v"(fr), "+v"(fq));
        Unit u = uu; u.pn = (uu.pn >= 4 && uu.pn < 12) ? (uu.pn < 8 ? uu.pn + 4 : uu.pn - 4) : uu.pn;
        const int row0 = u.pm * BM + wr * 64 + fr, col0 = u.pn * BM + wc * 32 + 4 * fq;
        const int b = u.pm >> 3, sblk = u.pm & 7;
        if (u.pn < 8) {
            const bool isK = u.pn >= 4;
            LAS float* P = xl;
            LAS float* KMS = xl + 2048;
#pragma unroll
            for (int ai = 0; ai < 2; ++ai)
#pragma unroll
                for (int m = 0; m < 4; ++m)
#pragma unroll
                    for (int bj = 0; bj < 2; ++bj) { const f32x4 x0 = acc[ai][bj][m][0], x1 = acc[ai][bj][m][1];
                        float ssq = (x0[0] * x0[0] + x0[1] * x0[1]) + (x0[2] * x0[2] + x0[3] * x0[3]) + (x1[0] * x1[0] + x1[1] * x1[1]) + (x1[2] * x1[2] + x1[3] * x1[3]);
                        ssq += swz_xor<16>(ssq); ssq = add_x32(ssq, (fq * 16 + fr));
                        if (fq == 0) P[((ai * HALF + wr * 64 + m * 16 + fr) * 2 + bj) * 4 + wc] = ssq; }
            asm volatile("s_waitcnt lgkmcnt(0)" ::: "memory"); __builtin_amdgcn_s_barrier(); asm volatile("" ::: "memory");
            const float* gg = isK ? gk : gq;
            const int dl = 16 * wc + 4 * fq;
            const f32x4 g0 = *(const f32x4*)(gg + dl), g1 = *(const f32x4*)(gg + 64 + dl);
            f32x4 km0[2], km1[2];
#pragma unroll
            for (int bj = 0; bj < 2; ++bj) { km0[bj] = (f32x4){0.f, 0.f, 0.f, 0.f}; km1[bj] = (f32x4){0.f, 0.f, 0.f, 0.f}; }
            bf16_t* dbase = (isK ? K : Q) + ((size_t)(b * 8 + (u.pn & 3) * 2) * 2048 + sblk * 256) * 128 + dl;
#pragma unroll
            for (int ai = 0; ai < 2; ++ai)
#pragma unroll
                for (int m = 0; m < 4; ++m) { const int rl = ai * HALF + wr * 64 + m * 16 + fr; const size_t grow = (size_t)u.pm * BM + rl;
                    const f32x4 cs = *(const f32x4*)(cosT + grow * 64 + dl), sn = *(const f32x4*)(sinT + grow * 64 + dl);
#pragma unroll
                    for (int bj = 0; bj < 2; ++bj) { const f32x4 pp = *(const LAS f32x4*)(P + (rl * 2 + bj) * 4);
                        const float rstd = 1.0f / sqrtf(((pp[0] + pp[1]) + (pp[2] + pp[3])) * (1.0f / 128.0f) + 1e-6f);
                        const f32x4 n0 = acc[ai][bj][m][0] * rstd * g0, n1 = acc[ai][bj][m][1] * rstd * g1;
                        const f32x4 o0 = n0 * cs - n1 * sn, o1 = n1 * cs + n0 * sn;
                        bf16_t* dp = dbase + ((size_t)bj * 2048 + rl) * 128;
                        u32x2 w0, w1; w0.x = pk2(o0[0], o0[1]); w0.y = pk2(o0[2], o0[3]); w1.x = pk2(o1[0], o1[1]); w1.y = pk2(o1[2], o1[3]);
                        *(u32x2*)dp = w0; *(u32x2*)(dp + 64) = w1;
                        km0[bj] += o0; km1[bj] += o1; }
                    asm volatile("" ::: "memory"); }
            if (isK) {
#pragma unroll
                for (int bj = 0; bj < 2; ++bj)
#pragma unroll
                    for (int j = 0; j < 4; ++j) { float a0 = km0[bj][j], a1 = km1[bj][j];
                        a0 += swz_xor<1>(a0); a0 += swz_xor<2>(a0); a0 += swz_xor<4>(a0); a0 += swz_xor<8>(a0);
                        a1 += swz_xor<1>(a1); a1 += swz_xor<2>(a1); a1 += swz_xor<4>(a1); a1 += swz_xor<8>(a1);
                        if (fr == 0) { KMS[(wr * 2 + bj) * 128 + dl + j] = a0; KMS[(wr * 2 + bj) * 128 + 64 + dl + j] = a1; } }
                asm volatile("s_waitcnt lgkmcnt(0)" ::: "memory"); __builtin_amdgcn_s_barrier(); asm volatile("" ::: "memory");
                const int t = (wr * 4 + wc) * 64 + fq * 16 + fr;
                if (t < 256) { const int bj = t >> 7, d = t & 127;
                    kmean[((size_t)(b * 8 + (u.pn & 3) * 2 + bj) * 8 + sblk) * 128 + d] = (KMS[bj * 128 + d] + KMS[(2 + bj) * 128 + d]) * (1.0f / 256.0f); }
            }
            return;
        }
        if (u.pn < 12) {
            const int s0 = sblk * BM + wr * 64 + fr;
#pragma unroll
            for (int bj = 0; bj < 2; ++bj) { bf16_t* hp = V + ((size_t)(b * 8 + (u.pn - 8) * 2 + bj) * 2048 + s0) * 128 + wc * 32 + 4 * fq;
#pragma unroll
                for (int ai = 0; ai < 2; ++ai)
#pragma unroll
                    for (int m = 0; m < 4; ++m)
#pragma unroll
                        for (int n = 0; n < 2; ++n) { const f32x4 v = acc[ai][bj][m][n]; u32x2 w; w.x = pk2(v[0], v[1]); w.y = pk2(v[2], v[3]); *(u32x2*)(hp + (size_t)(ai * HALF + m * 16) * 128 + n * 16) = w; } }
            return;
        }
#pragma unroll
        for (int ai = 0; ai < 2; ++ai)
#pragma unroll
            for (int m = 0; m < 4; ++m) { bf16_t* rowp = Z + (size_t)(row0 + ai * HALF + m * 16) * ldc + col0;
#pragma unroll
                for (int bj = 0; bj < 2; ++bj)
#pragma unroll
                    for (int n = 0; n < 2; ++n) { const f32x4 v = acc[ai][bj][m][n]; u32x2 w; w.x = pk2(v[0], v[1]); w.y = pk2(v[2], v[3]); *(u32x2*)(rowp + bj * HALF + n * 16) = w; } }
    }
};
struct EpiScaleBf16 {
    static constexpr bool AFTER_DRAIN = false;
    bf16_t* O; int ldc; const float* scale;
    __device__ __forceinline__ void operator()(const f32x4 (&acc)[2][2][4][2], const Unit& u, int wr, int wc, int fr, int fq) const {
        const int row0 = u.pm * BM + wr * 64 + fr, col0 = u.pn * BM + wc * 32 + 4 * fq;
        f32x4 sv[2][2];
#pragma unroll
        for (int bj = 0; bj < 2; ++bj)
#pragma unroll
            for (int n = 0; n < 2; ++n) sv[bj][n] = *(const f32x4*)(scale + col0 + bj * HALF + n * 16);
#pragma unroll
        for (int ai = 0; ai < 2; ++ai)
#pragma unroll
            for (int m = 0; m < 4; ++m) { bf16_t* rowp = O + (size_t)(row0 + ai * HALF + m * 16) * ldc + col0;
#pragma unroll
                for (int bj = 0; bj < 2; ++bj)
#pragma unroll
                    for (int n = 0; n < 2; ++n) { const f32x4 v = acc[ai][bj][m][n] * sv[bj][n]; u32x2 w; w.x = pk2(v[0], v[1]); w.y = pk2(v[2], v[3]); *(u32x2*)(rowp + bj * HALF + n * 16) = w; } }
    }
};
struct EpiGateRes {
    static constexpr bool AFTER_DRAIN = false;
    const float* base; float* out; int ldc; const float* gate; int ldg;
    __device__ __forceinline__ void operator()(const f32x4 (&acc)[2][2][4][2], const Unit& u, int wr, int wc, int fr, int fq) const {
        const int row0 = u.pm * BM + wr * 64 + fr, col0 = u.pn * BM + wc * 32 + 4 * fq;
        const float* gp = gate + (size_t)(u.pm >> 3) * ldg + col0;
        f32x4 gv[2][2];
#pragma unroll
        for (int bj = 0; bj < 2; ++bj)
#pragma unroll
            for (int n = 0; n < 2; ++n) gv[bj][n] = *(const f32x4*)(gp + bj * HALF + n * 16);
#pragma unroll
        for (int ai = 0; ai < 2; ++ai) {
            f32x4 bs[4][2][2];
#pragma unroll
            for (int m = 0; m < 4; ++m)
#pragma unroll
                for (int bj = 0; bj < 2; ++bj)
#pragma unroll
                    for (int n = 0; n < 2; ++n) bs[m][bj][n] = __builtin_nontemporal_load((const f32x4*)(base + (size_t)(row0 + ai * HALF + m * 16) * ldc + col0 + bj * HALF + n * 16));
#pragma unroll
            for (int m = 0; m < 4; ++m) { const size_t off = (size_t)(row0 + ai * HALF + m * 16) * ldc + col0;
#pragma unroll
                for (int bj = 0; bj < 2; ++bj)
#pragma unroll
                    for (int n = 0; n < 2; ++n) __builtin_nontemporal_store(bs[m][bj][n] + gv[bj][n] * acc[ai][bj][m][n], (f32x4*)(out + off + bj * HALF + n * 16)); }
            asm volatile("" ::: "memory"); }
    }
};
struct EpiGateResNorm {
    static constexpr bool AFTER_DRAIN = true;
    const float* base; float* out; int ldc; const float* gate; const float* gnorm; const float* sc; const float* sh; int ldg;
    bf16_t* xn; float* slots; unsigned* cnt;
    __device__ __forceinline__ void fused(f32x4 (&acc)[2][2][4][2], const Unit& u, int wr, int wc, int fr, int fq, LAS unsigned char* lds, int wid, int lane) const {
        LAS float* P = (LAS float*)lds;
        LAS float* S = (LAS float*)(lds + 4096);
        const int row0 = u.pm * BM + wr * 64 + fr, col0 = u.pn * BM + wc * 32 + 4 * fq, b = u.pm >> 3;
        {
            f32x4 gv[2][2];
#pragma unroll
            for (int bj = 0; bj < 2; ++bj)
#pragma unroll
                for (int n = 0; n < 2; ++n) gv[bj][n] = *(const f32x4*)(gate + (size_t)b * ldg + col0 + bj * HALF + n * 16);
#pragma unroll
            for (int ai = 0; ai < 2; ++ai) {
                f32x4 bs[4][2][2];
#pragma unroll
                for (int m = 0; m < 4; ++m)
#pragma unroll
                    for (int bj = 0; bj < 2; ++bj)
#pragma unroll
                        for (int n = 0; n < 2; ++n) bs[m][bj][n] = __builtin_nontemporal_load((const f32x4*)(base + (size_t)(row0 + ai * HALF + m * 16) * ldc + col0 + bj * HALF + n * 16));
#pragma unroll
                for (int m = 0; m < 4; ++m) { const size_t off = (size_t)(row0 + ai * HALF + m * 16) * ldc + col0; float ssq = 0.f;
#pragma unroll
                    for (int bj = 0; bj < 2; ++bj)
#pragma unroll
                        for (int n = 0; n < 2; ++n) { const f32x4 v = bs[m][bj][n] + gv[bj][n] * acc[ai][bj][m][n];
                            acc[ai][bj][m][n] = v; ssq += (v[0] * v[0] + v[1] * v[1]) + (v[2] * v[2] + v[3] * v[3]); }
                    ssq += swz_xor<16>(ssq); ssq = add_x32(ssq, (fq * 16 + fr));
                    if (fq == 0) P[(ai * HALF + wr * 64 + m * 16 + fr) * 4 + wc] = ssq; }
                asm volatile("" ::: "memory"); }
        }
        asm volatile("s_waitcnt lgkmcnt(0)" ::: "memory"); __builtin_amdgcn_s_barrier(); asm volatile("" ::: "memory");
        const int tid = wid * 64 + lane;
        if (tid < 256) { const f32x4 p = *(const LAS f32x4*)(P + tid * 4);
            __hip_atomic_store(slots + ((size_t)u.pm * 256 + tid) * 8 + u.pn, (p[0] + p[1]) + (p[2] + p[3]), __ATOMIC_RELAXED, __HIP_MEMORY_SCOPE_AGENT); }
        asm volatile("s_waitcnt vmcnt(0)" ::: "memory");
        if (tid < 256 && lane == 0) __hip_atomic_fetch_add(cnt + 64 * u.pm, 1u, __ATOMIC_RELAXED, __HIP_MEMORY_SCOPE_AGENT);
#define X1_STORES() do { _Pragma("unroll") for (int ai = 0; ai < 2; ++ai) _Pragma("unroll") for (int m = 0; m < 4; ++m) { const size_t off = (size_t)(row0 + ai * HALF + m * 16) * ldc + col0; \
            _Pragma("unroll") for (int bj = 0; bj < 2; ++bj) _Pragma("unroll") for (int n = 0; n < 2; ++n) __builtin_nontemporal_store(acc[ai][bj][m][n], (f32x4*)(out + off + bj * HALF + n * 16)); } } while (0)
        if (wid != 0) X1_STORES();
        if (wid == 0) {
            unsigned sp = 0;
            while ((unsigned)__builtin_amdgcn_readfirstlane((int)__hip_atomic_load(cnt + 64 * u.pm, __ATOMIC_RELAXED, __HIP_MEMORY_SCOPE_AGENT)) < 32u) { __builtin_amdgcn_s_sleep(2); if (++sp > (1u << 22)) break; }
            __builtin_amdgcn_fence(__ATOMIC_ACQUIRE, "agent");
            asm volatile("s_waitcnt vmcnt(0)" ::: "memory");
            X1_STORES();
        }
#undef X1_STORES
        asm volatile("s_waitcnt lgkmcnt(0)" ::: "memory"); __builtin_amdgcn_s_barrier(); asm volatile("" ::: "memory");
        if (tid < 256) { const float* sl = slots + ((size_t)u.pm * 256 + tid) * 8; float t = 0.f;
#pragma unroll
            for (int k = 0; k < 8; ++k) t += __hip_atomic_load(sl + k, __ATOMIC_RELAXED, __HIP_MEMORY_SCOPE_AGENT);
            S[tid] = 1.0f / sqrtf(t * (1.0f / 2048.0f) + 1e-6f); }
        asm volatile("s_waitcnt lgkmcnt(0)" ::: "memory"); __builtin_amdgcn_s_barrier(); asm volatile("" ::: "memory");
        f32x4 av[2][2], sv[2][2];
#pragma unroll
        for (int bj = 0; bj < 2; ++bj)
#pragma unroll
            for (int n = 0; n < 2; ++n) { const int c = col0 + bj * HALF + n * 16; const f32x4 g4 = *(const f32x4*)(gnorm + c), s4 = *(const f32x4*)(sc + (size_t)b * ldg + c);
                av[bj][n] = g4 * (s4 + 1.0f); sv[bj][n] = *(const f32x4*)(sh + (size_t)b * ldg + c); }
#pragma unroll
        for (int ai = 0; ai < 2; ++ai)
#pragma unroll
            for (int m = 0; m < 4; ++m) { const int rl = ai * HALF + wr * 64 + m * 16 + fr; const float rstd = S[rl]; bf16_t* rowp = xn + (size_t)(u.pm * BM + rl) * ldc + col0;
#pragma unroll
                for (int bj = 0; bj < 2; ++bj)
#pragma unroll
                    for (int n = 0; n < 2; ++n) { const f32x4 o = acc[ai][bj][m][n] * rstd * av[bj][n] + sv[bj][n]; u32x2 w; w.x = pk2(o[0], o[1]); w.y = pk2(o[2], o[3]); *(u32x2*)(rowp + bj * HALF + n * 16) = w; } }
    }
};
struct EpiSwiGLU {
    static constexpr bool AFTER_DRAIN = false;
    bf16_t* H; int ldc; int bjsel;
    __device__ __forceinline__ void operator()(const f32x4 (&acc)[2][2][4][2], const Unit& u, int wr, int wc, int fr, int fq) const {
        const int row0 = u.pm * BM + wr * 64 + fr;
#pragma unroll
        for (int ai = 0; ai < 2; ++ai)
#pragma unroll
            for (int m = 0; m < 4; ++m) { bf16_t* rowp = H + (size_t)(row0 + ai * HALF + m * 16) * ldc;
#pragma unroll
                for (int bj = 0; bj < 2; ++bj) { if (bjsel >= 0 && bj != bjsel) continue; const int G = u.pn * 8 + bj * 4 + wc; const f32x4 gt = acc[ai][bj][m][0], up = acc[ai][bj][m][1]; f32x4 o;
#pragma unroll
                    for (int j = 0; j < 4; ++j) { const float e = __builtin_amdgcn_exp2f(gt[j] * -1.4426950408889634f); o[j] = gt[j] * __builtin_amdgcn_rcpf(1.0f + e) * up[j]; }
                    u32x2 w; w.x = pk2(o[0], o[1]); w.y = pk2(o[2], o[3]); *(u32x2*)(rowp + 16 * G + 4 * fq) = w; } }
    }
};
}

struct Args {
    const float* x; const float* c; const int* pos; const float* w_ada; const float* b_ada; const float* g_mix; const float* w_in; const float* g_q; const float* g_k;
    const float* w_pool; const float* pool_scale; const float* w_out; const float* g_ffn; const float* w_gate; const float* w_up; const float* w_down;
    float* out; unsigned char* ws;
};

__device__ __forceinline__ void p0_ada(const Args& a, LAS float* ldsf) {
    const int tid = tid_fresh();
    for (int i = tid; i < NB * DM; i += NTHR) ldsf[i] = silu_f(a.c[i]);
    __syncthreads();
    float* part = (float*)(a.ws + WS_PART);
    LAS float* red = ldsf + NB * DM;
    const int l16 = tid & 15, rg = tid >> 4;
    for (int it = blockIdx.x; it < 768; it += gridDim.x) {
        const int cgp = it % 192, kq = it / 192;
        const int e0 = cgp * 64 + 4 * l16, d0 = kq * 512 + rg * 16;
        f32x4 acc[4];
#pragma unroll
        for (int b = 0; b < 4; ++b) acc[b] = (f32x4){0.f, 0.f, 0.f, 0.f};
        f32x4 w[16];
#pragma unroll
        for (int i = 0; i < 16; ++i) w[i] = __builtin_nontemporal_load((const f32x4*)(a.w_ada + (size_t)(d0 + i) * MODW + e0));
#pragma unroll
        for (int i = 0; i < 16; ++i)
#pragma unroll
            for (int b = 0; b < 4; ++b) acc[b] += w[i] * ldsf[b * DM + d0 + i];
#pragma unroll
        for (int b = 0; b < 4; ++b) *(LAS f32x4*)(red + (rg * 4 + b) * 64 + 4 * l16) = acc[b];
        __syncthreads();
        if (tid < 256) { const int b = tid >> 6, col = tid & 63; float s = 0.f;
#pragma unroll 8
            for (int r = 0; r < 32; ++r) s += red[(r * 4 + b) * 64 + col];
            part[(size_t)(kq * 4 + b) * MODW + cgp * 64 + col] = s; }
        __syncthreads();
    }
}
__device__ __forceinline__ void conv_item(const float* W, int N, bf16_t* WT, int ldt, int mode, LAS float* scr, int item, int lane) {
    const int nblk = N / 64, kb = item / nblk, nb = item % nblk, k0 = 64 * kb, n0 = 64 * nb;
    const int l32 = lane & 31, lh = lane >> 5;
    f32x2 v[32];
#pragma unroll
    for (int i = 0; i < 32; ++i) v[i] = __builtin_nontemporal_load((const f32x2*)(W + (size_t)(k0 + 2 * i + lh) * N + n0 + 2 * l32));
#pragma unroll
    for (int i = 0; i < 32; ++i) { const int kk = 2 * i + lh; scr[kk * 65 + 2 * l32] = v[i].x; scr[kk * 65 + 2 * l32 + 1] = v[i].y; }
    asm volatile("s_waitcnt lgkmcnt(0)" ::: "memory");
    const int c = lane & 7;
#pragma unroll
    for (int j = 0; j < 8; ++j) { const int n = (lane >> 3) + 8 * j; const LAS float* s = scr + (8 * c) * 65 + n;
        u32x4 o; o.x = pk2(s[0 * 65], s[1 * 65]); o.y = pk2(s[2 * 65], s[3 * 65]); o.z = pk2(s[4 * 65], s[5 * 65]); o.w = pk2(s[6 * 65], s[7 * 65]);
        const int gn = n0 + n; int row;
        if (mode == 0) row = gn;
        else if (mode == 3) { row = gn < 2 * AW ? ((gn & ~127) + 32 * ((gn & 63) >> 4) + 16 * ((gn >> 6) & 1) + (gn & 15)) : gn;
                              if (gn >= AW && gn < 3 * AW) row += (gn < 2 * AW) ? AW : -AW; }
        else row = 32 * (gn >> 4) + (gn & 15) + (mode == 2 ? 16 : 0);
        *(u32x4*)(WT + (size_t)row * ldt + k0 + 8 * c) = o; }
    asm volatile("s_waitcnt lgkmcnt(0)" ::: "memory");
}
template <int PART>
__device__ __forceinline__ void p0_convert(const Args& a, LAS unsigned char* lds, int wg, int nwg, const float* wdown) {
    const int tid = tid_fresh(), lane = tid & 63, wave = __builtin_amdgcn_readfirstlane(tid >> 6);
    LAS float* scr = (LAS float*)(lds + wave * 16640);
    const int gw = wg * NWAVES + wave, NGW = nwg * NWAVES;
    constexpr int I_IN = (DM / 64) * (INW / 64), I_OUT = (DM / 64) * (DM / 64), I_G = (DM / 64) * (DFF / 64), I_D = (DFF / 64) * (DM / 64), I_P = 16;
    if (PART == 1) { for (int it = gw; it < I_D; it += NGW) conv_item(wdown, DM, (bf16_t*)(a.ws + WS_WDN), DFF, 0, scr, it, lane); return; }
    constexpr int NIT = I_IN + I_OUT + 2 * I_G + 4 * I_P;
    bf16_t* wgu = (bf16_t*)(a.ws + WS_WGU);
    for (int it = gw; it < NIT; it += NGW) {
        int r = it;
        if (r < I_IN) { conv_item(a.w_in, INW, (bf16_t*)(a.ws + WS_WIN), DM, 3, scr, r, lane); continue; } r -= I_IN;
        if (r < I_OUT) { conv_item(a.w_out, DM, (bf16_t*)(a.ws + WS_WOUT), DM, 0, scr, r, lane); continue; } r -= I_OUT;
        if (r < I_G) { conv_item(a.w_gate, DFF, wgu, DM, 1, scr, r, lane); continue; } r -= I_G;
        if (r < I_G) { conv_item(a.w_up, DFF, wgu, DM, 2, scr, r, lane); continue; } r -= I_G;
        const int g = r / I_P; r -= g * I_P;
        conv_item(a.w_pool + (size_t)g * 65536, 256, (bf16_t*)(a.ws + WS_WPOOL) + (size_t)g * 65536, 256, 0, scr, r, lane);
    }
}

template <bool FROM_PART>
__device__ __forceinline__ void norm_phase(const Args& a, const float* X, const float* g, int sh_idx, int sc_idx, bf16_t* OUT, LAS float* ldsf) {
    const int tid = tid_fresh(), lane = tid & 63, wave = tid >> 6;
    const float* part = (const float*)(a.ws + WS_PART);
    float* mod = (float*)(a.ws + WS_MOD);
    if (FROM_PART) {
        for (int i = blockIdx.x * NTHR + tid; i < NB * MODW; i += gridDim.x * NTHR) { const int b = i / MODW, e = i % MODW;
            float s = a.b_ada[e];
#pragma unroll
            for (int kq = 0; kq < 4; ++kq) s += part[(size_t)(kq * 4 + b) * MODW + e];
            mod[i] = s; }
    }
    LAS float* sa = ldsf; LAS float* ss = ldsf + DM;
    int cur_b = -1;
    const float invf = (float)exp2(-(double)(tid & 63) * (13.287712379549449 / 64.0));
    for (int rb = blockIdx.x; rb < MTOK / 32; rb += gridDim.x) {
        const int b = rb / (SEQ / 32);
        if (FROM_PART) {
            float* ct = (float*)(a.ws + WS_COS) + (size_t)rb * 32 * 64; float* st = (float*)(a.ws + WS_SIN) + (size_t)rb * 32 * 64;
#pragma unroll
            for (int k = 0; k < 4; ++k) { const int idx = tid + NTHR * k; const float ang = (float)a.pos[rb * 32 + (idx >> 6)] * invf; float sn, cs; sincosf(ang, &sn, &cs); ct[idx] = cs; st[idx] = sn; }
        }
        if (b != cur_b) {
            __syncthreads();
            for (int d = tid; d < DM; d += NTHR) {
                float sc, sh;
                if (FROM_PART) { sc = a.b_ada[sc_idx * DM + d]; sh = a.b_ada[sh_idx * DM + d];
#pragma unroll
                    for (int kq = 0; kq < 4; ++kq) { sc += part[(size_t)(kq * 4 + b) * MODW + sc_idx * DM + d]; sh += part[(size_t)(kq * 4 + b) * MODW + sh_idx * DM + d]; } }
                else { sc = mod[(size_t)b * MODW + sc_idx * DM + d]; sh = mod[(size_t)b * MODW + sh_idx * DM + d]; }
                sa[d] = g[d] * (1.0f + sc); ss[d] = sh; }
            __syncthreads();
            cur_b = b;
        }
#pragma unroll 1
        for (int i = 0; i < 4; ++i) {
            const int row = rb * 32 + wave * 4 + i;
            const f32x4* xr = (const f32x4*)(X + (size_t)row * DM) + lane;
            f32x4 v[8]; float s = 0.f;
#pragma unroll
            for (int j = 0; j < 8; ++j) { v[j] = __builtin_nontemporal_load(xr + 64 * j); s += (v[j].x * v[j].x + v[j].y * v[j].y) + (v[j].z * v[j].z + v[j].w * v[j].w); }
            const float rstd = 1.0f / sqrtf(wave_sum(s, lane) * (1.0f / DM) + EPS);
            u32x2* op = (u32x2*)(OUT + (size_t)row * DM) + lane;
#pragma unroll
            for (int j = 0; j < 8; ++j) { const int d = 4 * (lane + 64 * j); const f32x4 av = *(const LAS f32x4*)(sa + d), sv = *(const LAS f32x4*)(ss + d);
                const f32x4 o = v[j] * rstd * av + sv; u32x2 w; w.x = pk2(o[0], o[1]); w.y = pk2(o[2], o[3]); op[64 * j] = w; }
        }
    }
    __syncthreads();
}

__device__ __forceinline__ f32x4 ld_bf4(const bf16_t* p) { const u32x2 w = __builtin_nontemporal_load((const u32x2*)p); return (f32x4){__builtin_bit_cast(float, w.x << 16), __builtin_bit_cast(float, w.x & 0xffff0000u), __builtin_bit_cast(float, w.y << 16), __builtin_bit_cast(float, w.y & 0xffff0000u)}; }
template <int W>
__device__ __forceinline__ void p3_pool(const bf16_t* zc, bf16_t* pb, int s0) {
    f32x4 prev[W - 1], u[16];
#pragma unroll
    for (int j = 0; j < W - 1; ++j) { const int k = (W - 1) - j; prev[j] = (s0 - k >= 0) ? ld_bf4(zc - (long)k * INW) : (f32x4){0.f, 0.f, 0.f, 0.f}; }
#pragma unroll
    for (int i = 0; i < 16; ++i) u[i] = ld_bf4(zc + (size_t)i * INW);
    f32x4 acc = (f32x4){0.f, 0.f, 0.f, 0.f};
#pragma unroll
    for (int j = 0; j < W - 1; ++j) acc += prev[j];
#pragma unroll
    for (int i = 0; i < 16; ++i) {
        const int t = s0 + i;
        acc += u[i];
        const float inv = 1.0f / (float)(t + 1 < W ? t + 1 : W);
        const f32x4 o = acc * inv - u[i];
        u32x2 w; w.x = pk2(o[0], o[1]); w.y = pk2(o[2], o[3]); *(u32x2*)(pb + (size_t)i * PW) = w;
        acc -= (i - W + 1 >= 0) ? u[(i - W + 1 >= 0) ? i - W + 1 : 0] : prev[(i < W - 1) ? i : 0];
    }
}
__device__ __forceinline__ void p3_unit(const Args& a, int rb, int cgi, LAS float* ldsf) {
    const int tid = tid_fresh(), lane = tid & 63, wave = tid >> 6;
    const bf16_t* Z = (const bf16_t*)(a.ws + WS_ZF);
    const int b = rb >> 3, sblk = rb & 7;
    const int row0 = rb * 256 + wave * 32, s0 = sblk * 256 + wave * 32;
    if (cgi < 16) {
        const int head = cgi & 7; const bool isK = cgi >= 8;
        const float* gg = isK ? a.g_k : a.g_q;
        const int sub = lane >> 4, d0 = 4 * (lane & 15);
        const f32x4 g0 = *(const f32x4*)(gg + d0), g1 = *(const f32x4*)(gg + 64 + d0);
        bf16_t* dst = (bf16_t*)(a.ws + (isK ? WS_K : WS_Q)) + ((size_t)(b * NH + head) * SEQ + s0 + sub) * HD + d0;
        const bf16_t* zp = Z + (size_t)(row0 + sub) * INW + cgi * 128 + d0;
        const float* ct = (const float*)(a.ws + WS_COS) + (size_t)(row0 + sub) * 64 + d0;
        const float* st = (const float*)(a.ws + WS_SIN) + (size_t)(row0 + sub) * 64 + d0;
        f32x4 km0 = (f32x4){0.f, 0.f, 0.f, 0.f}, km1 = (f32x4){0.f, 0.f, 0.f, 0.f};
#pragma unroll 4
        for (int p = 0; p < 8; ++p) {
            const f32x4 x0 = ld_bf4(zp + (size_t)(4 * p) * INW), x1 = ld_bf4(zp + (size_t)(4 * p) * INW + 64);
            const f32x4 cs = *(const f32x4*)(ct + (size_t)(4 * p) * 64), sn = *(const f32x4*)(st + (size_t)(4 * p) * 64);
            float ssq = (x0[0] * x0[0] + x0[1] * x0[1]) + (x0[2] * x0[2] + x0[3] * x0[3]) + (x1[0] * x1[0] + x1[1] * x1[1]) + (x1[2] * x1[2] + x1[3] * x1[3]);
            ssq += swz_xor<1>(ssq); ssq += swz_xor<2>(ssq); ssq += swz_xor<4>(ssq); ssq += swz_xor<8>(ssq);
            const float rstd = 1.0f / sqrtf(ssq * (1.0f / HD) + EPS);
            const f32x4 n0 = x0 * rstd * g0, n1 = x1 * rstd * g1;
            const f32x4 o0 = n0 * cs - n1 * sn, o1 = n1 * cs + n0 * sn;
            u32x2 w0, w1; w0.x = pk2(o0[0], o0[1]); w0.y = pk2(o0[2], o0[3]); w1.x = pk2(o1[0], o1[1]); w1.y = pk2(o1[2], o1[3]);
            *(u32x2*)(dst + (size_t)(4 * p) * HD) = w0; *(u32x2*)(dst + (size_t)(4 * p) * HD + 64) = w1;
            km0 += o0; km1 += o1;
        }
        if (isK) {
#pragma unroll
            for (int j = 0; j < 4; ++j) { km0[j] += swz_xor<16>(km0[j]); km0[j] = add_x32(km0[j], lane); km1[j] += swz_xor<16>(km1[j]); km1[j] = add_x32(km1[j], lane); }
            if (sub == 0) { *(LAS f32x4*)(ldsf + wave * 128 + d0) = km0; *(LAS f32x4*)(ldsf + wave * 128 + 64 + d0) = km1; }
            __syncthreads();
            if (tid < 128) { float s = 0.f;
#pragma unroll
                for (int w = 0; w < 8; ++w) s += ldsf[w * 128 + tid];
                ((float*)(a.ws + WS_KMEAN))[((size_t)(b * NH + head) * NBLK + sblk) * HD + tid] = s * (1.0f / MBLK); }
            __syncthreads();
        }
    } else {
        const int uc0 = (cgi - 24) * 128, grp = (cgi - 24) >> 1;
        const int hrow = 16 * (lane >> 5), c4 = 4 * (lane & 31);
        const bf16_t* zc = Z + (size_t)(row0 + hrow) * INW + 3 * AW + uc0 + c4;
        bf16_t* pb = (bf16_t*)(a.ws + WS_PB) + (size_t)(row0 + hrow) * PW + uc0 + c4;
        if (grp == 0) p3_pool<2>(zc, pb, s0 + hrow); else if (grp == 1) p3_pool<4>(zc, pb, s0 + hrow); else if (grp == 2) p3_pool<8>(zc, pb, s0 + hrow); else p3_pool<16>(zc, pb, s0 + hrow);
    }
}

constexpr int AT_NS = 4, AT_SLOT = 32768, AT_KM = AT_NS * AT_SLOT;
typedef short v4i16_t __attribute__((ext_vector_type(4)));
__device__ __forceinline__ void glds16(const void* gsrc, unsigned lds_dst) { unsigned keep;
    asm volatile("s_mov_b32 %0, m0\n\ts_mov_b32 m0, %2\n\ts_nop 0\n\tglobal_load_lds_dwordx4 %1, off\n\ts_mov_b32 m0, %0" : "=&s"(keep) : "v"(gsrc), "s"(lds_dst) : "memory"); }
__device__ __forceinline__ void attn_unit(const Args& a, int bh, int qb, int half, LAS unsigned char* lds) {
    const int tid = tid_fresh(), lane = tid & 63, wave = __builtin_amdgcn_readfirstlane(tid >> 6), r = lane & 15, q4 = lane >> 4;
    const int qrow0 = half * 128 + wave * 16;
    const bf16_t* Qg = (const bf16_t*)(a.ws + WS_Q) + ((size_t)bh * SEQ + qb * MBLK + qrow0) * HD;
    const bf16_t* Kg = (const bf16_t*)(a.ws + WS_K) + (size_t)bh * SEQ * HD;
    const bf16_t* Vg = (const bf16_t*)(a.ws + WS_VT) + (size_t)bh * SEQ * HD;
    const float* KM = (const float*)(a.ws + WS_KMEAN) + (size_t)bh * NBLK * HD;
    LAS float* kml = (LAS float*)(lds + AT_KM);
    asm volatile("s_waitcnt vmcnt(0)" ::: "memory");
    for (int i = tid; i < qb * HD; i += NTHR) kml[i] = KM[i];
    bf16x8 Qf[4];
#pragma unroll
    for (int kk = 0; kk < 4; ++kk) Qf[kk] = __builtin_nontemporal_load((const bf16x8*)(Qg + (size_t)r * HD + 32 * kk + 8 * q4));
    const int nown = half ? 4 : 2, NT = nown + 4 * qb;
    unsigned koff[2], voff[2];
#pragma unroll
    for (int i = 0; i < 2; ++i) { const int row = 4 * (2 * wave + i) + (lane >> 4), pc = lane & 15;
        koff[i] = (unsigned)(row * HD + ((pc ^ (row & 15)) * 8)) * 2u;
        voff[i] = (unsigned)(row * HD + ((pc ^ (((row & 3) << 2) | ((row >> 2) & 3))) * 8)) * 2u; }
#define AT_ISSUE(t) do { const int own_ = (t) < nown; const int blk_ = own_ ? qb : (((t) - nown) >> 2), T_ = own_ ? (t) : (((t) - nown) & 3); const size_t gb_ = (size_t)(blk_ * MBLK + 64 * T_) * HD * 2; \
        const unsigned sl_ = (unsigned)__builtin_amdgcn_readfirstlane((int)(lds0 + ((t) & 3) * AT_SLOT + wave * 2048)); \
        _Pragma("unroll") for (int i_ = 0; i_ < 2; ++i_) { \
            glds16((const char*)Kg + gb_ + koff[i_], sl_ + i_ * 1024); \
            glds16((const char*)Vg + gb_ + voff[i_], sl_ + 16384 + i_ * 1024); } } while (0)
    const unsigned lds0 = (unsigned)(size_t)lds;
    AT_ISSUE(0); if (NT > 1) AT_ISSUE(1); if (NT > 2) AT_ISSUE(2);
    __syncthreads();
    unsigned sel;
    {
        float gate[7];
#pragma unroll
        for (int j = 0; j < 7; ++j) {
            float gsum = -INFINITY;
            if (j < qb) { float s = 0.f;
#pragma unroll
                for (int kk = 0; kk < 4; ++kk) { const f32x4 k0 = *(const LAS f32x4*)(kml + j * HD + 32 * kk + 8 * q4), k1 = *(const LAS f32x4*)(kml + j * HD + 32 * kk + 8 * q4 + 4);
                    const bf16x8 qv = Qf[kk];
                    s += bf2f((unsigned short)qv[0]) * k0[0] + bf2f((unsigned short)qv[1]) * k0[1] + bf2f((unsigned short)qv[2]) * k0[2] + bf2f((unsigned short)qv[3]) * k0[3]
                       + bf2f((unsigned short)qv[4]) * k1[0] + bf2f((unsigned short)qv[5]) * k1[1] + bf2f((unsigned short)qv[6]) * k1[2] + bf2f((unsigned short)qv[7]) * k1[3]; }
                s += swz_xor<16>(s); s = add_x32(s, lane); gsum = s; }
            gate[j] = gsum;
        }
        unsigned m = 0u;
#pragma unroll
        for (int j = 0; j < 7; ++j) { int cnt = 0;
#pragma unroll
            for (int i = 0; i < 7; ++i) if (i != j) cnt += (gate[i] > gate[j] || (gate[i] == gate[j] && i < j)) ? 1 : 0;
            if (cnt < 3) m |= 1u << j; }
        sel = m & ((1u << qb) - 1u);
    }
    f32x4 o[8];
#pragma unroll
    for (int dt = 0; dt < 8; ++dt) o[dt] = (f32x4){0.f, 0.f, 0.f, 0.f};
    float mref = -INFINITY, lrun = 0.f;
    constexpr float SC = 0.08838834764831845f * 1.4426950408889634f;
    constexpr float THR = 8.0f;
    const int qi = qrow0 + r;
    const int pir = 8 * ((r >> 2) & 1) + 4 * (r >> 3) + (r & 3);
    const int kbase_g = 8 * (q4 & 1) + 4 * (q4 >> 1);
    int kaddr[4];
#pragma unroll
    for (int kk = 0; kk < 4; ++kk) kaddr[kk] = pir * 256 + (((4 * kk + q4) ^ pir) * 16);
    const int fg = (2 * (q4 & 1) + (q4 >> 1)) & 3, vq = r >> 2, vp = r & 3;
    int vaddr[8];
#pragma unroll
    for (int dt = 0; dt < 8; ++dt) vaddr[dt] = 16384 + (kbase_g + vq) * 256 + (((2 * dt + (vp >> 1)) ^ ((vq << 2) | fg)) * 16) + 8 * (vp & 1);
    for (int t = 0; t < NT; ++t) {
        if (t + 2 < NT) asm volatile("s_waitcnt vmcnt(8)" ::: "memory"); else if (t + 1 < NT) asm volatile("s_waitcnt vmcnt(4)" ::: "memory"); else asm volatile("s_waitcnt vmcnt(0)" ::: "memory");
        __builtin_amdgcn_s_barrier(); asm volatile("" ::: "memory");
        if (t + 3 < NT) AT_ISSUE(t + 3);
        const bool own = t < nown; const int blk = own ? qb : ((t - nown) >> 2), T = own ? t : ((t - nown) & 3);
        const bool lsel = own ? true : ((sel >> blk) & 1u) != 0u;
        const bool active = own ? (64 * T <= qrow0 + 15) : (__any((int)lsel) != 0);
        if (active) {
            const LAS unsigned char* sl = lds + (t & 3) * AT_SLOT;
            f32x4 s[4];
            bf16x8 kf[4][4];
#pragma unroll
            for (int kk = 0; kk < 4; ++kk)
#pragma unroll
                for (int kt = 0; kt < 4; ++kt) kf[kk][kt] = *(const LAS bf16x8*)(sl + kaddr[kk] + kt * 4096);
            __builtin_amdgcn_sched_barrier(0);
#pragma unroll
            for (int kt = 0; kt < 4; ++kt) s[kt] = (f32x4){0.f, 0.f, 0.f, 0.f};
#pragma unroll
            for (int kk = 0; kk < 4; ++kk)
#pragma unroll
                for (int kt = 0; kt < 4; ++kt) s[kt] = __builtin_amdgcn_mfma_f32_16x16x32_bf16(kf[kk][kt], Qf[kk], s[kt], 0, 0, 0);
            v4i16_t vlo[2][8], vhi[2][8];
#pragma unroll
            for (int dt = 0; dt < 8; ++dt) { vlo[0][dt] = __builtin_amdgcn_ds_read_tr16_b64_v4i16((LAS v4i16_t*)(sl + vaddr[dt])); vhi[0][dt] = __builtin_amdgcn_ds_read_tr16_b64_v4i16((LAS v4i16_t*)(sl + vaddr[dt] + 4096)); }
            __builtin_amdgcn_sched_barrier(0);
            if (own && 64 * T + 63 > qrow0) {
#pragma unroll
                for (int kt = 0; kt < 4; ++kt)
#pragma unroll
                    for (int j = 0; j < 4; ++j) if (64 * T + 16 * kt + kbase_g + j > qi) s[kt][j] = -INFINITY; }
            float mx = max3f(s[0][0], s[0][1], s[0][2]);
            mx = max3f(mx, s[0][3], s[1][0]); mx = max3f(mx, s[1][1], s[1][2]); mx = max3f(mx, s[1][3], s[2][0]); mx = max3f(mx, s[2][1], s[2][2]);
            mx = max3f(mx, s[2][3], s[3][0]); mx = max3f(mx, s[3][1], s[3][2]); mx = fmaxf(mx, s[3][3]);
            mx = lsel ? mx : -INFINITY;
            mx = fmaxf(mx, swz_xor<16>(mx)); mx = max_x32(mx, lane);
            mx *= SC;
            if (__any((int)(mx > mref + THR))) {
                const float mnew = fmaxf(mref, mx); const float alpha = __builtin_amdgcn_exp2f(mref - mnew);
                mref = mnew; lrun *= alpha;
#pragma unroll
                for (int dt = 0; dt < 8; ++dt) o[dt] *= alpha;
            }
            const float negm = lsel ? -mref : -INFINITY;
            const f32x2 negm2 = {negm, negm}, sc2 = {SC, SC};
            f32x2 ps2 = {0.f, 0.f};
            unsigned pw[8];
#pragma unroll
            for (int kt = 0; kt < 4; ++kt)
#pragma unroll
                for (int h = 0; h < 2; ++h) { f32x2 v = {s[kt][2 * h], s[kt][2 * h + 1]}; v = v * sc2 + negm2;
                    f32x2 p; p.x = __builtin_amdgcn_exp2f(v.x); p.y = __builtin_amdgcn_exp2f(v.y); ps2 += p; pw[2 * kt + h] = pk2(p.x, p.y); }
            lrun += ps2.x + ps2.y;
            bf16x8 P[2];
#pragma unroll
            for (int c = 0; c < 2; ++c) { u32x4 w; w.x = pw[4 * c]; w.y = pw[4 * c + 1]; w.z = pw[4 * c + 2]; w.w = pw[4 * c + 3]; P[c] = __builtin_bit_cast(bf16x8, w); }
            __builtin_amdgcn_sched_barrier(0);
#pragma unroll
            for (int dt = 0; dt < 8; ++dt) { vlo[1][dt] = __builtin_amdgcn_ds_read_tr16_b64_v4i16((LAS v4i16_t*)(sl + vaddr[dt] + 8192)); vhi[1][dt] = __builtin_amdgcn_ds_read_tr16_b64_v4i16((LAS v4i16_t*)(sl + vaddr[dt] + 8192 + 4096)); }
            __builtin_amdgcn_sched_barrier(0);
#pragma unroll
            for (int c = 0; c < 2; ++c) {
#pragma unroll
                for (int dt = 0; dt < 8; ++dt) { const v4i16_t lo = vlo[c][dt], hi = vhi[c][dt];
                    const bf16x8 vf = (bf16x8){lo[0], lo[1], lo[2], lo[3], hi[0], hi[1], hi[2], hi[3]};
                    o[dt] = __builtin_amdgcn_mfma_f32_16x16x32_bf16(vf, P[c], o[dt], 0, 0, 0); }
                __builtin_amdgcn_sched_barrier(0);
            }
        }
    }
    asm volatile("s_waitcnt lgkmcnt(0)" ::: "memory");
    __builtin_amdgcn_s_barrier(); asm volatile("" ::: "memory");
#undef AT_ISSUE
    const int b = bh >> 3, h = bh & 7;
    float l = lrun; l += swz_xor<16>(l); l = add_x32(l, lane);
    const float il = 1.0f / l;
    bf16_t* op = (bf16_t*)(a.ws + WS_OC) + ((size_t)b * SEQ + qb * MBLK + qi) * DM + h * HD + 4 * q4;
#pragma unroll
    for (int dt = 0; dt < 8; ++dt) { const f32x4 v = o[dt] * il; u32x2 w; w.x = pk2(v[0], v[1]); w.y = pk2(v[2], v[3]); *(u32x2*)(op + 16 * dt) = w; }
}

#define XB_TMO      128
#define XB_XCNT(j)  (256  + 64 * (j))
#define XB_XSUB(j)  (1280 + 64 * (j))
#define XB_XGEN(j)  (2304 + 64 * (j))
#define XB_TOP      3328
#define XB_TOPGEN   3392
#define XCD_BAR_WORDS 3456
#define XB_SPIN_CAP (1u << 18)
__device__ __forceinline__ unsigned xb_ld(unsigned* p)              { return __hip_atomic_load(p, __ATOMIC_RELAXED, __HIP_MEMORY_SCOPE_AGENT); }
__device__ __forceinline__ unsigned xb_add(unsigned* p, unsigned v) { return __hip_atomic_fetch_add(p, v, __ATOMIC_RELAXED, __HIP_MEMORY_SCOPE_AGENT); }
__device__ __forceinline__ unsigned xb_xcc_id() { return (unsigned)__builtin_amdgcn_s_getreg((3 << 11) | 20) & 0xFu; }
#define XB_SPIN(cond, bar) do { unsigned _sp = 0; while (cond) { __builtin_amdgcn_s_sleep(1); \
    if ((++_sp & 255u) == 0u) { if (xb_ld(&(bar)[XB_TMO])) break; if (_sp > XB_SPIN_CAP) { atomicAdd(&(bar)[XB_TMO], 1u); break; } } } } while (0)
struct XcdBarrier { unsigned* bar; unsigned x; volatile LAS unsigned* st; };
__device__ __forceinline__ XcdBarrier xcd_barrier_post(unsigned* bar, volatile LAS unsigned* st) {
    XcdBarrier b; b.bar = bar; b.x = xb_xcc_id(); b.st = st;
    if (threadIdx.x == 0) (void)xb_add(&bar[XB_XCNT(b.x)], 1u);
    return b;
}
__device__ __forceinline__ void xcd_barrier_complete(unsigned* bar, unsigned x, unsigned& nloc, unsigned& nx) {
    const unsigned G = gridDim.x * gridDim.y * gridDim.z;
    unsigned sum, cnt, mine, sp = 0u;
    for (;;) {
        sum = 0u; cnt = 0u; mine = 0u;
#pragma unroll
        for (unsigned j = 0; j < 16; ++j) { const unsigned c = xb_ld(&bar[XB_XCNT(j)]); sum += c; cnt += (c > 0u) ? 1u : 0u; mine = (j == x) ? c : mine; }
        if (sum == G) break;
        __builtin_amdgcn_s_sleep(1);
        if ((++sp & 255u) == 0u) { if (xb_ld(&bar[XB_TMO])) break; if (sp > XB_SPIN_CAP) { atomicAdd(&bar[XB_TMO], 1u); break; } }
    }
    nloc = mine > 0u ? mine : 1u; nx = cnt > 0u ? cnt : 1u;
}
__device__ __forceinline__ void xcd_barrier(const XcdBarrier& b) {
    asm volatile("s_waitcnt vmcnt(0)" ::: "memory");
    __syncthreads();
    if (threadIdx.x == 0) {
        unsigned* bar = b.bar;
        const unsigned bx_ = xb_xcc_id();
        __builtin_amdgcn_s_waitcnt(0);
        unsigned nloc = b.st[0], nx = b.st[1];
        if (nloc == 0u) { xcd_barrier_complete(bar, bx_, nloc, nx); b.st[0] = nloc; b.st[1] = nx; }
        const unsigned old = xb_add(&bar[XB_XSUB(bx_)], 1u);
        const unsigned gen = old / nloc;
        if (old + 1u == (gen + 1u) * nloc) {
            __builtin_amdgcn_fence(__ATOMIC_RELEASE, "agent");
            asm volatile("s_waitcnt vmcnt(0)" ::: "memory");
            const unsigned og = xb_add(&bar[XB_TOP], 1u);
            const unsigned tg = og / nx;
            if (og + 1u == (tg + 1u) * nx) xb_add(&bar[XB_TOPGEN], 1u);
            else XB_SPIN(xb_ld(&bar[XB_TOPGEN]) == tg, bar);
            __builtin_amdgcn_fence(__ATOMIC_ACQUIRE, "agent");
            xb_add(&bar[XB_XGEN(bx_)], 1u);
            asm volatile("s_waitcnt vmcnt(0)" ::: "memory");
        } else {
            XB_SPIN(xb_ld(&bar[XB_XGEN(bx_)]) == gen, bar);
            __builtin_amdgcn_fence(__ATOMIC_ACQUIRE, "agent");
            asm volatile("s_waitcnt vmcnt(0)" ::: "memory");
        }
    }
    __syncthreads();
}

__global__ void __launch_bounds__(NTHR, 2) hymba_fwd(Args a) {
    extern __shared__ __attribute__((aligned(16))) unsigned char lds_raw[];
    LAS unsigned char* lds = (LAS unsigned char*)lds_raw;
    LAS float* ldsf = (LAS float*)lds_raw;
    cg::grid_group grid = cg::this_grid();
    const int G = gridDim.x, bx = blockIdx.x;
    unsigned char* ws = a.ws;
    volatile LAS unsigned* bst = (volatile LAS unsigned*)(lds + LDS_BYTES - 64);
    volatile LAS unsigned long long* stash = (volatile LAS unsigned long long*)(lds + LDS_BYTES - 128);
    if (threadIdx.x < 2) bst[threadIdx.x] = 0u;
    if (threadIdx.x == 0) { stash[0] = (unsigned long long)a.pool_scale; stash[1] = (unsigned long long)a.x; stash[2] = (unsigned long long)a.out; stash[3] = (unsigned long long)a.g_ffn; stash[4] = (unsigned long long)a.w_down; }
    __syncthreads();
#define STASHED(T, i) ((T)(((unsigned long long)(unsigned)__builtin_amdgcn_readfirstlane((int)(stash[i] & 0xffffffffull))) | ((unsigned long long)(unsigned)__builtin_amdgcn_readfirstlane((int)(stash[i] >> 32)) << 32)))
    const XcdBarrier bar = xcd_barrier_post((unsigned*)(ws + WS_CTL), bst);
#define GRID_BAR() xcd_barrier(bar)
#ifndef DUPMASK
#define DUPMASK 0
#endif
#define REP(k) for (int rep_ = 0; rep_ < (((DUPMASK) >> (k)) & 1 ? 2 : 1); ++rep_)

    if (a.ws == nullptr) grid.sync();
    { p0_ada(a, ldsf);
    if ((DUPMASK) & 256) { __syncthreads(); p0_ada(a, ldsf); }
    p0_convert<0>(a, lds, bx, G, nullptr);
    if ((DUPMASK) & 512) { __syncthreads(); p0_convert<0>(a, lds, bx, G, nullptr); }
    GRID_BAR(); }
    REP(1) { norm_phase<true>(a, a.x, a.g_mix, 0, 1, (bf16_t*)(ws + WS_XN), ldsf);
    GRID_BAR(); }
    REP(2) { pg8::Gemm g{(const bf16_t*)(ws + WS_XN), (const bf16_t*)(ws + WS_WIN), MTOK, INW, DM, DM, DM}; pg8::StaticOrder S; S.init(MTOK, INW, G, bx);
      pg8::EpiF32 E{(bf16_t*)(ws + WS_ZF), INW, (bf16_t*)(ws + WS_VT), (bf16_t*)(ws + WS_Q), (bf16_t*)(ws + WS_K), (float*)(ws + WS_KMEAN), a.g_q, a.g_k, (const float*)(ws + WS_COS), (const float*)(ws + WS_SIN), (LAS float*)(lds + 131072)};
      pg8::gemm_phase<pg8::EpiF32, pg8::StaticOrder, true>(lds, g, S, E);
    GRID_BAR(); }
    REP(4) {
    for (int u = bx; u < 256; u += G) {
        const int x = u & 7, i = u >> 3, s2 = i >> 4, j = i & 15, qb = j >> 1, hf = j & 1;
        attn_unit(a, x + 8 * s2, qb, hf, lds); __syncthreads();
        attn_unit(a, x + 16 + 8 * s2, 7 - qb, 1 - hf, lds); __syncthreads(); }
    for (int w = G - 1 - bx; w < 128; w += G) {
        const int grp = w >> 5, pm = w & 31;
        p3_unit(a, pm, 24 + 2 * grp, ldsf); p3_unit(a, pm, 25 + 2 * grp, ldsf);
        asm volatile("s_waitcnt vmcnt(0)" ::: "memory"); __syncthreads();
        pg8::Gemm g{(const bf16_t*)(ws + WS_PB) + grp * 256, (const bf16_t*)(ws + WS_WPOOL) + (size_t)grp * 65536, MTOK, 256, 256, PW, 256};
        pg8::OneUnit S{pm, 0, 1};
        pg8::EpiScaleBf16 E{(bf16_t*)(ws + WS_OC) + AW + grp * 256, DM, STASHED(const float*, 0) + grp * 256};
        pg8::gemm_phase<pg8::EpiScaleBf16, pg8::OneUnit, true>(lds, g, S, E);
    }
    if (rep_ == 0) { const float* wd = STASHED(const float*, 4);
        const int w = G - 1 - bx;
        if (G > 128) { if (w >= 128) p0_convert<1>(a, lds, w - 128, G - 128, wd); } else p0_convert<1>(a, lds, bx, G, wd); }
    GRID_BAR(); }
    if (G == 256) {
      REP(5) { pg8::Gemm g{(const bf16_t*)(ws + WS_OC), (const bf16_t*)(ws + WS_WOUT), MTOK, DM, DM, DM, DM}; pg8::StaticOrder S; S.init(MTOK, DM, G, bx);
      const float* mod = (const float*)(ws + WS_MOD);
      pg8::EpiGateResNorm E{STASHED(const float*, 1), STASHED(float*, 2), DM, mod + 2 * DM, STASHED(const float*, 3), mod + 4 * DM, mod + 3 * DM, MODW, (bf16_t*)(ws + WS_XN), (float*)(ws + WS_SLOTS), (unsigned*)(ws + WS_CTL) + CW_PANEL + rep_ * 2048};
      pg8::gemm_phase<pg8::EpiGateResNorm, pg8::StaticOrder, true>(lds, g, S, E);
      GRID_BAR(); }
    } else {
      { pg8::Gemm g{(const bf16_t*)(ws + WS_OC), (const bf16_t*)(ws + WS_WOUT), MTOK, DM, DM, DM, DM}; pg8::StaticOrder S; S.init(MTOK, DM, G, bx);
      pg8::EpiGateRes E{STASHED(const float*, 1), STASHED(float*, 2), DM, (const float*)(ws + WS_MOD) + 2 * DM, MODW};
      pg8::gemm_phase<pg8::EpiGateRes, pg8::StaticOrder, true>(lds, g, S, E);
      GRID_BAR(); }
      norm_phase<false>(a, STASHED(const float*, 2), STASHED(const float*, 3), 3, 4, (bf16_t*)(ws + WS_XN), ldsf);
      GRID_BAR();
    }
    REP(7) { pg8::Gemm g{(const bf16_t*)(ws + WS_XN), (const bf16_t*)(ws + WS_WGU), MTOK, 2 * DFF, DM, DM, DM}; pg8::StaticOrder S; S.init(MTOK, 2 * DFF, G, bx);
      const bool tail = (G == 256);
      if (tail) S.lim = (S.nwg / G) * G;
      { pg8::EpiSwiGLU E{(bf16_t*)(ws + WS_ZF), DFF, -1};
        pg8::gemm_phase<pg8::EpiSwiGLU, pg8::StaticOrder, true>(lds, g, S, E); }
      if (tail) {
          pg8::Unit tu; const int hw = bx >> 7;
          const bool has = S.at(S.lim + (bx & 127), tu);
          pg8::OneUnit S1{tu.pm, tu.pn, has ? 1 : 0};
          pg8::EpiSwiGLU E{(bf16_t*)(ws + WS_ZF), DFF, hw};
          if (hw == 0) pg8::gemm_phase<pg8::EpiSwiGLU, pg8::OneUnit, true, 0>(lds, g, S1, E); else pg8::gemm_phase<pg8::EpiSwiGLU, pg8::OneUnit, true, 1>(lds, g, S1, E);
      }
    GRID_BAR(); }
    { pg8::Gemm g{(const bf16_t*)(ws + WS_ZF), (const bf16_t*)(ws + WS_WDN), MTOK, DM, DFF, DFF, DFF}; pg8::StaticOrder S; S.init(MTOK, DM, G, bx);
      float* outp = STASHED(float*, 2);
      pg8::EpiGateRes E{outp, outp, DM, (const float*)(ws + WS_MOD) + 5 * DM, MODW};
      pg8::gemm_phase<pg8::EpiGateRes, pg8::StaticOrder, true>(lds, g, S, E); }
}

extern "C" void kernel_launch(void* const* d_in, const int* in_sizes, int n_in, void* d_out, int out_size, void* d_ws, size_t ws_size, hipStream_t stream) {
    static int grid = 0;
    if (grid == 0) {
        if (n_in != 16 || out_size != MTOK * DM || ws_size < WS_END) { fprintf(stderr, "kernel_launch: unexpected problem (n_in %d, out %d, ws %zu)\n", n_in, out_size, ws_size); grid = -1; return; }
        int dev = 0, cus = 0, per_cu = 0;
        hipGetDevice(&dev);
        hipDeviceGetAttribute(&cus, hipDeviceAttributeMultiprocessorCount, dev);
        if (hipFuncSetAttribute((const void*)hymba_fwd, hipFuncAttributeMaxDynamicSharedMemorySize, LDS_BYTES) != hipSuccess) { fprintf(stderr, "kernel_launch: hipFuncSetAttribute failed\n"); grid = -1; return; }
        if (hipOccupancyMaxActiveBlocksPerMultiprocessor(&per_cu, (const void*)hymba_fwd, NTHR, LDS_BYTES) != hipSuccess || per_cu < 1) { fprintf(stderr, "kernel_launch: occupancy query gave %d\n", per_cu); per_cu = 1; }
        (void)hipGetLastError();
        grid = cus * per_cu;
    }
    if (grid < 0) return;
    Args a{};
    a.x = (const float*)d_in[0]; a.c = (const float*)d_in[1]; a.pos = (const int*)d_in[2]; a.w_ada = (const float*)d_in[3]; a.b_ada = (const float*)d_in[4];
    a.g_mix = (const float*)d_in[5]; a.w_in = (const float*)d_in[6]; a.g_q = (const float*)d_in[7]; a.g_k = (const float*)d_in[8]; a.w_pool = (const float*)d_in[9];
    a.pool_scale = (const float*)d_in[10]; a.w_out = (const float*)d_in[11]; a.g_ffn = (const float*)d_in[12]; a.w_gate = (const float*)d_in[13]; a.w_up = (const float*)d_in[14];
    a.w_down = (const float*)d_in[15]; a.out = (float*)d_out; a.ws = (unsigned char*)d_ws;
    if (hipMemsetAsync((char*)d_ws + WS_CTL, 0, CTL_ZERO_BYTES, stream) != hipSuccess) { fprintf(stderr, "kernel_launch: memset of control words failed\n"); return; }
    void* args[] = {&a};
    hipError_t e = hipLaunchCooperativeKernel((const void*)hymba_fwd, dim3(grid), dim3(NTHR), args, LDS_BYTES, stream);
    if (e != hipSuccess) fprintf(stderr, "kernel_launch: cooperative launch failed: %s (grid %d)\n", hipGetErrorString(e), grid);
}
```

```cpp
#include <hip/hip_runtime.h>
#include <hip/hip_cooperative_groups.h>
#include <cstdio>
#include <cstdint>
#include <cmath>
namespace cg = cooperative_groups;

#define LAS __attribute__((address_space(3)))
typedef unsigned short bf16_t;
typedef short bf16x8 __attribute__((ext_vector_type(8)));
typedef short s16x4 __attribute__((ext_vector_type(4)));
typedef float f32x4 __attribute__((ext_vector_type(4)));
typedef float f32x2 __attribute__((ext_vector_type(2)));
typedef unsigned u32x4 __attribute__((ext_vector_type(4)));
typedef unsigned u32x2 __attribute__((ext_vector_type(2)));

constexpr int DM = 2048, NB = 4, SEQ = 2048, MTOK = NB * SEQ;
constexpr int NH = 8, HD = 128, AW = 1024, PW = 1024, INW = 4096, DFF = 5632, NMOD = 6, MODW = NMOD * DM;
constexpr int MBLK = 256, NBLK = SEQ / MBLK;
constexpr float EPS = 1e-6f;
constexpr int NTHR = 512, NWAVES = 8;

constexpr size_t MiB = 1u << 20;
constexpr size_t WS_CTL = 0, CTL_ZERO_BYTES = 65536;
constexpr size_t WS_SLOTS = 512 * 1024;
constexpr int CW_PANEL = 4096;
constexpr size_t WS_PART = 1 * MiB;
constexpr size_t WS_MOD = 2 * MiB;
constexpr size_t WS_KMEAN = 3 * MiB;
constexpr size_t WS_WIN = 4 * MiB;
constexpr size_t WS_WOUT = 20 * MiB;
constexpr size_t WS_WGU = 28 * MiB;
constexpr size_t WS_WDN = 72 * MiB;
constexpr size_t WS_WPOOL = 94 * MiB;
constexpr size_t WS_XN = 96 * MiB;
constexpr size_t WS_ZF = 128 * MiB;
constexpr size_t WS_Q = 256 * MiB;
constexpr size_t WS_K = 272 * MiB;
constexpr size_t WS_VT = 288 * MiB;
constexpr size_t WS_PB = 304 * MiB;
constexpr size_t WS_OC = 320 * MiB;
constexpr size_t WS_COS = 352 * MiB;
constexpr size_t WS_SIN = 354 * MiB;
constexpr size_t WS_END = 356 * MiB;

constexpr int LDS_BYTES = 147456;

__device__ __forceinline__ unsigned f2bf(float f) { unsigned u = __builtin_bit_cast(unsigned, f); return (u + 0x7fffu + ((u >> 16) & 1u)) >> 16; }
typedef __bf16 bf16x2_hw __attribute__((ext_vector_type(2)));
__device__ __forceinline__ unsigned pk2(float lo, float hi) { f32x2 v = {lo, hi}; bf16x2_hw b = __builtin_convertvector(v, bf16x2_hw); return __builtin_bit_cast(unsigned, b); }
__device__ __forceinline__ float bf2f(unsigned short h) { return __builtin_bit_cast(float, (unsigned)h << 16); }
template <int M> __device__ __forceinline__ float swz_xor(float v) { return __builtin_bit_cast(float, __builtin_amdgcn_ds_swizzle(__builtin_bit_cast(int, v), (M << 10) | 0x1f)); }
__device__ __forceinline__ float get_x32(float v, int lane) { return __builtin_bit_cast(float, __builtin_amdgcn_ds_bpermute((lane ^ 32) << 2, __builtin_bit_cast(int, v))); }
__device__ __forceinline__ float add_x32(float v, int lane) { return v + get_x32(v, lane); }
__device__ __forceinline__ float max_x32(float v, int lane) { return fmaxf(v, get_x32(v, lane)); }
__device__ __forceinline__ float wave_sum(float v, int lane) {
    v += swz_xor<1>(v); v += swz_xor<2>(v); v += swz_xor<4>(v); v += swz_xor<8>(v); v += swz_xor<16>(v);
    return add_x32(v, lane);
}
__device__ __forceinline__ int tid_fresh() { int t = threadIdx.x; asm volatile("" : "+v"(t)); return t; }
__device__ __forceinline__ float max3f(float a, float b, float c) { float r; asm("v_max3_f32 %0, %1, %2, %3" : "=v"(r) : "v"(a), "v"(b), "v"(c)); return r; }
__device__ __forceinline__ float silu_f(float v) { return v / (1.0f + __expf(-v)); }

namespace pg8 {
constexpr int BM = 256, BK = 64, HALF = 128, HTB = HALF * BK * 2, STAGE_BYTES = 8 * HTB, NXCD = 8, WGM = 8;
__host__ __device__ __forceinline__ int lds_byte(int r, int c) { const int st = (r >> 4) * 2 + (c >> 5), rr = r & 15, cc = c & 31, ob = rr * 64 + cc * 2; return st * 1024 + (ob ^ (((ob >> 9) & 1) << 5)); }
__host__ __device__ __forceinline__ void stage_rc(int b, int& R, int& C) { const int st = b / 1024, sb = b % 1024, swz = sb ^ (((sb >> 9) & 1) << 5); R = (st >> 1) * 16 + swz / 64; C = (st & 1) * 32 + (swz % 64) / 2; }

struct Unit { int pm, pn; };
struct Gemm { const bf16_t* A; const bf16_t* Bt; int M, N, K, lda, ldb; };

struct StaticOrder {
    int nM, nN, nwg, G, c, lim;
    __device__ void init(int M, int N, int G_, int c_) { nM = M / BM; nN = N / BM; nwg = nM * nN; G = G_; c = c_; lim = nwg; }
    __device__ bool at(int L, Unit& u) const { return deal((long)L, u); }
    __device__ bool next(int i, Unit& u) const { const long L = (long)i * G + c; if (L >= lim) return false; return deal(L, u); }
    __device__ bool deal(long L, Unit& u) const {
        if (L >= nwg) return false;
        int wgid = (int)L; { const int q = nwg / NXCD, r = nwg % NXCD, xcd = wgid % NXCD, off = wgid / NXCD; wgid = (xcd < r ? xcd * (q + 1) : r * (q + 1) + (xcd - r) * q) + off; }
        const int nig = WGM * nN, gid = wgid / nig, fm = gid * WGM, gsz = (nM - fm) < WGM ? (nM - fm) : WGM;
        u.pm = fm + ((wgid % nig) % gsz); u.pn = (wgid % nig) / gsz; return true;
    }
};
struct OneUnit {
    int pm, pn, has;
    __device__ bool next(int i, Unit& u) const { if (i > 0 || !has) return false; u.pm = pm; u.pn = pn; return true; }
};

template <class Epi, class Sched, bool ALIGN_EPI, int NB = 2>
__device__ __forceinline__ void gemm_phase(LAS unsigned char* lds, const Gemm g, const Sched& S, const Epi& E) {
    const int tid = tid_fresh(), wid = __builtin_amdgcn_readfirstlane(tid >> 6), lane = tid & 63, wr = wid >> 2, wc = wid & 3, fr = lane & 15, fq = lane >> 4;
    const int K = g.K, nt = K / BK;
    unsigned voffA[2], voffB[2];
#pragma unroll
    for (int i = 0; i < 2; ++i) { int R, C; stage_rc(tid * 16 + i * 8192, R, C);
        voffA[i] = (unsigned)(R * g.lda + C) * 2u; voffB[i] = (unsigned)(R * g.ldb + C) * 2u; }
    const size_t kstep = (size_t)(BK * 2);
    const size_t hstepA = (size_t)HALF * g.lda * 2, hstepB = (size_t)HALF * g.ldb * 2;
    const size_t tstepA = 2 * hstepA, tstepB = 2 * hstepB;
    const unsigned ldsw = (unsigned)wid * 1024u;
    const int aoff = lds_byte(wr * 64 + fr, fq * 8), boff = lds_byte(wc * 32 + fr, fq * 8);
#define PG8_SA(b, h) (((b) * 2 + (h)) * HTB)
#define PG8_SB(b, h) ((4 + (b) * 2 + (h)) * HTB)
#define PG8_STAGE(bufoff, gbase, voff) do { _Pragma("unroll") for (int _i = 0; _i < 2; ++_i) \
        __builtin_amdgcn_global_load_lds((const unsigned*)((const char*)(gbase) + (voff)[_i]), (LAS unsigned*)(lds + (bufoff) + ldsw + _i * 8192), 16, 0, 0); } while (0)
#define PG8_LDA(dst, b, h) do { _Pragma("unroll") for (int m = 0; m < 4; ++m) _Pragma("unroll") for (int k = 0; k < 2; ++k) dst[m][k] = *(const LAS bf16x8*)(lds + PG8_SA(b, h) + aoff + m * 2048 + k * 1024); } while (0)
#define PG8_LDB(dst, b, h) do { _Pragma("unroll") for (int n = 0; n < 2; ++n) _Pragma("unroll") for (int k = 0; k < 2; ++k) dst[n][k] = *(const LAS bf16x8*)(lds + PG8_SB(b, h) + boff + n * 2048 + k * 1024); } while (0)
#define PG8_MMA(ai, bj, At, Bt) do { __builtin_amdgcn_s_setprio(1); _Pragma("unroll") for (int m = 0; m < 4; ++m) _Pragma("unroll") for (int n = 0; n < 2; ++n) _Pragma("unroll") for (int k = 0; k < 2; ++k) \
        acc[ai][bj][m][n] = __builtin_amdgcn_mfma_f32_16x16x32_bf16(Bt[n][k], At[m][k], acc[ai][bj][m][n], 0, 0, 0); __builtin_amdgcn_s_setprio(0); } while (0)
#define PG8_WAIT_V(n) asm volatile("s_waitcnt vmcnt(" #n ")" ::: "memory")
#define PG8_WAIT_L(n) asm volatile("s_waitcnt lgkmcnt(" #n ")" ::: "memory")
#define PG8_BAR __builtin_amdgcn_s_barrier()
#define PG8_SCHED __builtin_amdgcn_sched_barrier(0)
    Unit cur, nxt; int ui = 0;
    if (!S.next(0, cur)) return;
    f32x4 acc[2][2][4][2];
#pragma unroll
    for (int a = 0; a < 2; ++a)
#pragma unroll
        for (int b = 0; b < 2; ++b)
#pragma unroll
            for (int m = 0; m < 4; ++m)
#pragma unroll
                for (int n = 0; n < 2; ++n) acc[a][b][m][n] = (f32x4){0.f, 0.f, 0.f, 0.f};
    bf16x8 At[4][2], B0[2][2], B1[2][2];
    const char* cA = (const char*)g.A + (size_t)cur.pm * tstepA; const char* cB = (const char*)g.Bt + (size_t)cur.pn * tstepB;
    constexpr bool FULL = (NB == 2); constexpr int BJ = FULL ? 0 : NB;
    if constexpr (FULL) {
    PG8_STAGE(PG8_SB(0, 0), cB, voffB); PG8_STAGE(PG8_SB(0, 1), cB + hstepB, voffB); PG8_STAGE(PG8_SA(0, 0), cA, voffA); PG8_STAGE(PG8_SA(0, 1), cA + hstepA, voffA);
    if (wr == 1) PG8_BAR;
    PG8_WAIT_V(2); PG8_BAR;
    PG8_STAGE(PG8_SB(1, 0), cB + kstep, voffB); PG8_STAGE(PG8_SA(1, 0), cA + kstep, voffA); PG8_STAGE(PG8_SB(1, 1), cB + hstepB + kstep, voffB);
    PG8_WAIT_V(6); PG8_BAR;
    } else {
    PG8_STAGE(PG8_SB(0, BJ), cB + BJ * hstepB, voffB); PG8_STAGE(PG8_SA(0, 0), cA, voffA); PG8_STAGE(PG8_SA(0, 1), cA + hstepA, voffA);
    if (wr == 1) PG8_BAR;
    PG8_WAIT_V(2); PG8_BAR;
    PG8_STAGE(PG8_SB(1, BJ), cB + BJ * hstepB + kstep, voffB); PG8_STAGE(PG8_SA(1, 0), cA + kstep, voffA);
    PG8_WAIT_V(4); PG8_BAR;
    }
    for (;;) {
        const bool has_next = S.next(ui + 1, nxt);
        const char* nA = has_next ? (const char*)g.A + (size_t)nxt.pm * tstepA : cA; const char* nB = has_next ? (const char*)g.Bt + (size_t)nxt.pn * tstepB : cB;
        for (int t = 0; t < nt; t += 2) {
            const bool last = (t == nt - 2);
            const char* a1 = cA + (size_t)(t + 1) * kstep;
            const char* a2 = last ? nA : cA + (size_t)(t + 2) * kstep; const char* b2 = last ? nB : cB + (size_t)(t + 2) * kstep;
            const char* a3 = a2 + kstep; const char* b3 = b2 + kstep;
            if constexpr (FULL) {
            PG8_LDB(B0, 0, 0); PG8_LDB(B1, 0, 1); PG8_SCHED; PG8_LDA(At, 0, 0); PG8_STAGE(PG8_SA(1, 1), a1 + hstepA, voffA);
            PG8_WAIT_V(8); PG8_WAIT_L(0); PG8_BAR; PG8_MMA(0, 0, At, B0); PG8_MMA(0, 1, At, B1); PG8_BAR; PG8_SCHED;
            PG8_LDA(At, 0, 1); PG8_STAGE(PG8_SB(0, 0), b2, voffB); PG8_STAGE(PG8_SB(0, 1), b2 + hstepB, voffB); PG8_STAGE(PG8_SA(0, 0), a2, voffA);
            PG8_WAIT_V(8); PG8_WAIT_L(0); PG8_BAR; PG8_MMA(1, 0, At, B0); PG8_MMA(1, 1, At, B1); PG8_BAR; PG8_SCHED;
            PG8_LDB(B0, 1, 0); PG8_LDB(B1, 1, 1); PG8_SCHED; PG8_LDA(At, 1, 0); PG8_STAGE(PG8_SA(0, 1), a2 + hstepA, voffA);
            PG8_WAIT_V(8); PG8_WAIT_L(0); PG8_BAR; PG8_MMA(0, 0, At, B0); PG8_MMA(0, 1, At, B1); PG8_BAR; PG8_SCHED;
            PG8_LDA(At, 1, 1); PG8_STAGE(PG8_SB(1, 0), b3, voffB); PG8_STAGE(PG8_SB(1, 1), b3 + hstepB, voffB); PG8_STAGE(PG8_SA(1, 0), a3, voffA);
            PG8_WAIT_V(8); PG8_WAIT_L(0); PG8_BAR; PG8_MMA(1, 0, At, B0); PG8_MMA(1, 1, At, B1); PG8_BAR; PG8_SCHED;
            } else {
            PG8_LDB(B0, 0, BJ); PG8_SCHED; PG8_LDA(At, 0, 0); PG8_STAGE(PG8_SA(1, 1), a1 + hstepA, voffA);
            PG8_WAIT_V(6); PG8_WAIT_L(0); PG8_BAR; PG8_MMA(0, BJ, At, B0); PG8_BAR; PG8_SCHED;
            PG8_LDA(At, 0, 1); PG8_STAGE(PG8_SB(0, BJ), b2 + BJ * hstepB, voffB); PG8_STAGE(PG8_SA(0, 0), a2, voffA);
            PG8_WAIT_V(6); PG8_WAIT_L(0); PG8_BAR; PG8_MMA(1, BJ, At, B0); PG8_BAR; PG8_SCHED;
            PG8_LDB(B0, 1, BJ); PG8_SCHED; PG8_LDA(At, 1, 0); PG8_STAGE(PG8_SA(0, 1), a2 + hstepA, voffA);
            PG8_WAIT_V(6); PG8_WAIT_L(0); PG8_BAR; PG8_MMA(0, BJ, At, B0); PG8_BAR; PG8_SCHED;
            PG8_LDA(At, 1, 1); PG8_STAGE(PG8_SB(1, BJ), b3 + BJ * hstepB, voffB); PG8_STAGE(PG8_SA(1, 0), a3, voffA);
            PG8_WAIT_V(6); PG8_WAIT_L(0); PG8_BAR; PG8_MMA(1, BJ, At, B0); PG8_BAR; PG8_SCHED;
            }
        }
        if constexpr (ALIGN_EPI) { if (wr == 0) PG8_BAR; }
        if constexpr (!Epi::AFTER_DRAIN) E(acc, cur, wr, wc, fr, fq);
        if (!has_next) break;
#pragma unroll
        for (int a = 0; a < 2; ++a)
#pragma unroll
            for (int b = 0; b < 2; ++b)
#pragma unroll
                for (int m = 0; m < 4; ++m)
#pragma unroll
                    for (int n = 0; n < 2; ++n) acc[a][b][m][n] = (f32x4){0.f, 0.f, 0.f, 0.f};
        cur = nxt; cA = nA; cB = nB; ++ui;
        if constexpr (ALIGN_EPI) { if (wr == 1) PG8_BAR; }
    }
    PG8_WAIT_V(0);
    if constexpr (!ALIGN_EPI) { if (wr == 0) PG8_BAR; }
    PG8_BAR;
    if constexpr (Epi::AFTER_DRAIN) E.fused(acc, cur, wr, wc, fr, fq, lds, wid, lane);
#undef PG8_SA
#undef PG8_SB
#undef PG8_STAGE
#undef PG8_LDA
#undef PG8_LDB
#undef PG8_MMA
#undef PG8_WAIT_V
#undef PG8_WAIT_L
#undef PG8_BAR
#undef PG8_SCHED
}

struct EpiF32 {
    static constexpr bool AFTER_DRAIN = false;
    bf16_t* Z; int ldc; bf16_t* V; bf16_t* Q; bf16_t* K; float* kmean; const float* gq; const float* gk; const float* cosT; const float* sinT; LAS float* xl;
    __device__ __forceinline__ void operator()(const f32x4 (&acc)[2][2][4][2], const Unit& uu, int wr, int wc, int fr_in, int fq_in) const {
        int fr = fr_in, fq = fq_in; asm volatile("" : "+v"(fr), "+v"(fq));
        Unit u = uu; u.pn = (uu.pn >= 4 && uu.pn < 12) ? (uu.pn < 8 ? uu.pn + 4 : uu.pn - 4) : uu.pn;
        const int row0 = u.pm * BM + wr * 64 + fr, col0 = u.pn * BM + wc * 32 + 4 * fq;
        const int b = u.pm >> 3, sblk = u.pm & 7;
        if (u.pn < 8) {
            const bool isK = u.pn >= 4;
            LAS float* P = xl;
            LAS float* KMS = xl + 2048;
#pragma unroll
            for (int ai = 0; ai < 2; ++ai)
#pragma unroll
                for (int m = 0; m < 4; ++m)
#pragma unroll
                    for (int bj = 0; bj < 2; ++bj) { const f32x4 x0 = acc[ai][bj][m][0], x1 = acc[ai][bj][m][1];
                        float ssq = (x0[0] * x0[0] + x0[1] * x0[1]) + (x0[2] * x0[2] + x0[3] * x0[3]) + (x1[0] * x1[0] + x1[1] * x1[1]) + (x1[2] * x1[2] + x1[3] * x1[3]);
                        ssq += swz_xor<16>(ssq); ssq = add_x32(ssq, (fq * 16 + fr));
                        if (fq == 0) P[((ai * HALF + wr * 64 + m * 16 + fr) * 2 + bj) * 4 + wc] = ssq; }
            asm volatile("s_waitcnt lgkmcnt(0)" ::: "memory"); __builtin_amdgcn_s_barrier(); asm volatile("" ::: "memory");
            const float* gg = isK ? gk : gq;
            const int dl = 16 * wc + 4 * fq;
            const f32x4 g0 = *(const f32x4*)(gg + dl), g1 = *(const f32x4*)(gg + 64 + dl);
            f32x4 km0[2], km1[2];
#pragma unroll
            for (int bj = 0; bj < 2; ++bj) { km0[bj] = (f32x4){0.f, 0.f, 0.f, 0.f}; km1[bj] = (f32x4){0.f, 0.f, 0.f, 0.f}; }
            bf16_t* dbase = (isK ? K : Q) + ((size_t)(b * 8 + (u.pn & 3) * 2) * 2048 + sblk * 256) * 128 + dl;
#pragma unroll
            for (int ai = 0; ai < 2; ++ai)
#pragma unroll
                for (int m = 0; m < 4; ++m) { const int rl = ai * HALF + wr * 64 + m * 16 + fr; const size_t grow = (size_t)u.pm * BM + rl;
                    const f32x4 cs = *(const f32x4*)(cosT + grow * 64 + dl), sn = *(const f32x4*)(sinT + grow * 64 + dl);
#pragma unroll
                    for (int bj = 0; bj < 2; ++bj) { const f32x4 pp = *(const LAS f32x4*)(P + (rl * 2 + bj) * 4);
                        const float rstd = 1.0f / sqrtf(((pp[0] + pp[1]) + (pp[2] + pp[3])) * (1.0f / 128.0f) + 1e-6f);
                        const f32x4 n0 = acc[ai][bj][m][0] * rstd * g0, n1 = acc[ai][bj][m][1] * rstd * g1;
                        const f32x4 o0 = n0 * cs - n1 * sn, o1 = n1 * cs + n0 * sn;
                        bf16_t* dp = dbase + ((size_t)bj * 2048 + rl) * 128;
                        u32x2 w0, w1; w0.x = pk2(o0[0], o0[1]); w0.y = pk2(o0[2], o0[3]); w1.x = pk2(o1[0], o1[1]); w1.y = pk2(o1[2], o1[3]);
                        *(u32x2*)dp = w0; *(u32x2*)(dp + 64) = w1;
                        km0[bj] += o0; km1[bj] += o1; }
                    asm volatile("" ::: "memory"); }
            if (isK) {
#pragma unroll
                for (int bj = 0; bj < 2; ++bj)
#pragma unroll
                    for (int j = 0; j < 4; ++j) { float a0 = km0[bj][j], a1 = km1[bj][j];
                        a0 += swz_xor<1>(a0); a0 += swz_xor<2>(a0); a0 += swz_xor<4>(a0); a0 += swz_xor<8>(a0);
                        a1 += swz_xor<1>(a1); a1 += swz_xor<2>(a1); a1 += swz_xor<4>(a1); a1 += swz_xor<8>(a1);
                        if (fr == 0) { KMS[(wr * 2 + bj) * 128 + dl + j] = a0; KMS[(wr * 2 + bj) * 128 + 64 + dl + j] = a1; } }
                asm volatile("s_waitcnt lgkmcnt(0)" ::: "memory"); __builtin_amdgcn_s_barrier(); asm volatile("" ::: "memory");
                const int t = (wr * 4 + wc) * 64 + fq * 16 + fr;
                if (t < 256) { const int bj = t >> 7, d = t & 127;
                    kmean[((size_t)(b * 8 + (u.pn & 3) * 2 + bj) * 8 + sblk) * 128 + d] = (KMS[bj * 128 + d] + KMS[(2 + bj) * 128 + d]) * (1.0f / 256.0f); }
            }
            return;
        }
        if (u.pn < 12) {
            const int s0 = sblk * BM + wr * 64 + fr;
#pragma unroll
            for (int bj = 0; bj < 2; ++bj) { bf16_t* hp = V + ((size_t)(b * 8 + (u.pn - 8) * 2 + bj) * 2048 + s0) * 128 + wc * 32 + 4 * fq;
#pragma unroll
                for (int ai = 0; ai < 2; ++ai)
#pragma unroll
                    for (int m = 0; m < 4; ++m)
#pragma unroll
                        for (int n = 0; n < 2; ++n) { const f32x4 v = acc[ai][bj][m][n]; u32x2 w; w.x = pk2(v[0], v[1]); w.y = pk2(v[2], v[3]); *(u32x2*)(hp + (size_t)(ai * HALF + m * 16) * 128 + n * 16) = w; } }
            return;
        }
#pragma unroll
        for (int ai = 0; ai < 2; ++ai)
#pragma unroll
            for (int m = 0; m < 4; ++m) { bf16_t* rowp = Z + (size_t)(row0 + ai * HALF + m * 16) * ldc + col0;
#pragma unroll
                for (int bj = 0; bj < 2; ++bj)
#pragma unroll
                    for (int n = 0; n < 2; ++n) { const f32x4 v = acc[ai][bj][m][n]; u32x2 w; w.x = pk2(v[0], v[1]); w.y = pk2(v[2], v[3]); *(u32x2*)(rowp + bj * HALF + n * 16) = w; } }
    }
};
struct EpiScaleBf16 {
    static constexpr bool AFTER_DRAIN = false;
    bf16_t* O; int ldc; const float* scale;
    __device__ __forceinline__ void operator()(const f32x4 (&acc)[2][2][4][2], const Unit& u, int wr, int wc, int fr, int fq) const {
        const int row0 = u.pm * BM + wr * 64 + fr, col0 = u.pn * BM + wc * 32 + 4 * fq;
        f32x4 sv[2][2];
#pragma unroll
        for (int bj = 0; bj < 2; ++bj)
#pragma unroll
            for (int n = 0; n < 2; ++n) sv[bj][n] = *(const f32x4*)(scale + col0 + bj * HALF + n * 16);
#pragma unroll
        for (int ai = 0; ai < 2; ++ai)
#pragma unroll
            for (int m = 0; m < 4; ++m) { bf16_t* rowp = O + (size_t)(row0 + ai * HALF + m * 16) * ldc + col0;
#pragma unroll
                for (int bj = 0; bj < 2; ++bj)
#pragma unroll
                    for (int n = 0; n < 2; ++n) { const f32x4 v = acc[ai][bj][m][n] * sv[bj][n]; u32x2 w; w.x = pk2(v[0], v[1]); w.y = pk2(v[2], v[3]); *(u32x2*)(rowp + bj * HALF + n * 16) = w; } }
    }
};
struct EpiGateRes {
    static constexpr bool AFTER_DRAIN = false;
    const float* base; float* out; int ldc; const float* gate; int ldg;
    __device__ __forceinline__ void operator()(const f32x4 (&acc)[2][2][4][2], const Unit& u, int wr, int wc, int fr, int fq) const {
        const int row0 = u.pm * BM + wr * 64 + fr, col0 = u.pn * BM + wc * 32 + 4 * fq;
        const float* gp = gate + (size_t)(u.pm >> 3) * ldg + col0;
        f32x4 gv[2][2];
#pragma unroll
        for (int bj = 0; bj < 2; ++bj)
#pragma unroll
            for (int n = 0; n < 2; ++n) gv[bj][n] = *(const f32x4*)(gp + bj * HALF + n * 16);
#pragma unroll
        for (int ai = 0; ai < 2; ++ai) {
            f32x4 bs[4][2][2];
#pragma unroll
            for (int m = 0; m < 4; ++m)
#pragma unroll
                for (int bj = 0; bj < 2; ++bj)
#pragma unroll
                    for (int n = 0; n < 2; ++n) bs[m][bj][n] = __builtin_nontemporal_load((const f32x4*)(base + (size_t)(row0 + ai * HALF + m * 16) * ldc + col0 + bj * HALF + n * 16));
#pragma unroll
            for (int m = 0; m < 4; ++m) { const size_t off = (size_t)(row0 + ai * HALF + m * 16) * ldc + col0;
#pragma unroll
                for (int bj = 0; bj < 2; ++bj)
#pragma unroll
                    for (int n = 0; n < 2; ++n) __builtin_nontemporal_store(bs[m][bj][n] + gv[bj][n] * acc[ai][bj][m][n], (f32x4*)(out + off + bj * HALF + n * 16)); }
            asm volatile("" ::: "memory"); }
    }
};
struct EpiGateResNorm {
    static constexpr bool AFTER_DRAIN = true;
    const float* base; float* out; int ldc; const float* gate; const float* gnorm; const float* sc; const float* sh; int ldg;
    bf16_t* xn; float* slots; unsigned* cnt;
    __device__ __forceinline__ void fused(f32x4 (&acc)[2][2][4][2], const Unit& u, int wr, int wc, int fr, int fq, LAS unsigned char* lds, int wid, int lane) const {
        LAS float* P = (LAS float*)lds;
        LAS float* S = (LAS float*)(lds + 4096);
        const int row0 = u.pm * BM + wr * 64 + fr, col0 = u.pn * BM + wc * 32 + 4 * fq, b = u.pm >> 3;
        {
            f32x4 gv[2][2];
#pragma unroll
            for (int bj = 0; bj < 2; ++bj)
#pragma unroll
                for (int n = 0; n < 2; ++n) gv[bj][n] = *(const f32x4*)(gate + (size_t)b * ldg + col0 + bj * HALF + n * 16);
#pragma unroll
            for (int ai = 0; ai < 2; ++ai) {
                f32x4 bs[4][2][2];
#pragma unroll
                for (int m = 0; m < 4; ++m)
#pragma unroll
                    for (int bj = 0; bj < 2; ++bj)
#pragma unroll
                        for (int n = 0; n < 2; ++n) bs[m][bj][n] = __builtin_nontemporal_load((const f32x4*)(base + (size_t)(row0 + ai * HALF + m * 16) * ldc + col0 + bj * HALF + n * 16));
#pragma unroll
                for (int m = 0; m < 4; ++m) { const size_t off = (size_t)(row0 + ai * HALF + m * 16) * ldc + col0; float ssq = 0.f;
#pragma unroll
                    for (int bj = 0; bj < 2; ++bj)
#pragma unroll
                        for (int n = 0; n < 2; ++n) { const f32x4 v = bs[m][bj][n] + gv[bj][n] * acc[ai][bj][m][n];
                            acc[ai][bj][m][n] = v; ssq += (v[0] * v[0] + v[1] * v[1]) + (v[2] * v[2] + v[3] * v[3]); }
                    ssq += swz_xor<16>(ssq); ssq = add_x32(ssq, (fq * 16 + fr));
                    if (fq == 0) P[(ai * HALF + wr * 64 + m * 16 + fr) * 4 + wc] = ssq; }
                asm volatile("" ::: "memory"); }
        }
        asm volatile("s_waitcnt lgkmcnt(0)" ::: "memory"); __builtin_amdgcn_s_barrier(); asm volatile("" ::: "memory");
        const int tid = wid * 64 + lane;
        if (tid < 256) { const f32x4 p = *(const LAS f32x4*)(P + tid * 4);
            __hip_atomic_store(slots + ((size_t)u.pm * 256 + tid) * 8 + u.pn, (p[0] + p[1]) + (p[2] + p[3]), __ATOMIC_RELAXED, __HIP_MEMORY_SCOPE_AGENT); }
        asm volatile("s_waitcnt vmcnt(0)" ::: "memory");
        if (tid < 256 && lane == 0) __hip_atomic_fetch_add(cnt + 64 * u.pm, 1u, __ATOMIC_RELAXED, __HIP_MEMORY_SCOPE_AGENT);
#define X1_STORES() do { _Pragma("unroll") for (int ai = 0; ai < 2; ++ai) _Pragma("unroll") for (int m = 0; m < 4; ++m) { const size_t off = (size_t)(row0 + ai * HALF + m * 16) * ldc + col0; \
            _Pragma("unroll") for (int bj = 0; bj < 2; ++bj) _Pragma("unroll") for (int n = 0; n < 2; ++n) __builtin_nontemporal_store(acc[ai][bj][m][n], (f32x4*)(out + off + bj * HALF + n * 16)); } } while (0)
        if (wid != 0) X1_STORES();
        if (wid == 0) {
            unsigned sp = 0;
            while ((unsigned)__builtin_amdgcn_readfirstlane((int)__hip_atomic_load(cnt + 64 * u.pm, __ATOMIC_RELAXED, __HIP_MEMORY_SCOPE_AGENT)) < 32u) { __builtin_amdgcn_s_sleep(2); if (++sp > (1u << 22)) break; }
            __builtin_amdgcn_fence(__ATOMIC_ACQUIRE, "agent");
            asm volatile("s_waitcnt vmcnt(0)" ::: "memory");
            X1_STORES();
        }
#undef X1_STORES
        asm volatile("s_waitcnt lgkmcnt(0)" ::: "memory"); __builtin_amdgcn_s_barrier(); asm volatile("" ::: "memory");
        if (tid < 256) { const float* sl = slots + ((size_t)u.pm * 256 + tid) * 8; float t = 0.f;
#pragma unroll
            for (int k = 0; k < 8; ++k) t += __hip_atomic_load(sl + k, __ATOMIC_RELAXED, __HIP_MEMORY_SCOPE_AGENT);
            S[tid] = 1.0f / sqrtf(t * (1.0f / 2048.0f) + 1e-6f); }
        asm volatile("s_waitcnt lgkmcnt(0)" ::: "memory"); __builtin_amdgcn_s_barrier(); asm volatile("" ::: "memory");
        f32x4 av[2][2], sv[2][2];
#pragma unroll
        for (int bj = 0; bj < 2; ++bj)
#pragma unroll
            for (int n = 0; n < 2; ++n) { const int c = col0 + bj * HALF + n * 16; const f32x4 g4 = *(const f32x4*)(gnorm + c), s4 = *(const f32x4*)(sc + (size_t)b * ldg + c);
                av[bj][n] = g4 * (s4 + 1.0f); sv[bj][n] = *(const f32x4*)(sh + (size_t)b * ldg + c); }
#pragma unroll
        for (int ai = 0; ai < 2; ++ai)
#pragma unroll
            for (int m = 0; m < 4; ++m) { const int rl = ai * HALF + wr * 64 + m * 16 + fr; const float rstd = S[rl]; bf16_t* rowp = xn + (size_t)(u.pm * BM + rl) * ldc + col0;
#pragma unroll
                for (int bj = 0; bj < 2; ++bj)
#pragma unroll
                    for (int n = 0; n < 2; ++n) { const f32x4 o = acc[ai][bj][m][n] * rstd * av[bj][n] + sv[bj][n]; u32x2 w; w.x = pk2(o[0], o[1]); w.y = pk2(o[2], o[3]); *(u32x2*)(rowp + bj * HALF + n * 16) = w; } }
    }
};
struct EpiSwiGLU {
    static constexpr bool AFTER_DRAIN = false;
    bf16_t* H; int ldc; int bjsel;
    __device__ __forceinline__ void operator()(const f32x4 (&acc)[2][2][4][2], const Unit& u, int wr, int wc, int fr, int fq) const {
        const int row0 = u.pm * BM + wr * 64 + fr;
#pragma unroll
        for (int ai = 0; ai < 2; ++ai)
#pragma unroll
            for (int m = 0; m < 4; ++m) { bf16_t* rowp = H + (size_t)(row0 + ai * HALF + m * 16) * ldc;
#pragma unroll
                for (int bj = 0; bj < 2; ++bj) { if (bjsel >= 0 && bj != bjsel) continue; const int G = u.pn * 8 + bj * 4 + wc; const f32x4 gt = acc[ai][bj][m][0], up = acc[ai][bj][m][1]; f32x4 o;
#pragma unroll
                    for (int j = 0; j < 4; ++j) { const float e = __builtin_amdgcn_exp2f(gt[j] * -1.4426950408889634f); o[j] = gt[j] * __builtin_amdgcn_rcpf(1.0f + e) * up[j]; }
                    u32x2 w; w.x = pk2(o[0], o[1]); w.y = pk2(o[2], o[3]); *(u32x2*)(rowp + 16 * G + 4 * fq) = w; } }
    }
};
}

struct Args {
    const float* x; const float* c; const int* pos; const float* w_ada; const float* b_ada; const float* g_mix; const float* w_in; const float* g_q; const float* g_k;
    const float* w_pool; const float* pool_scale; const float* w_out; const float* g_ffn; const float* w_gate; const float* w_up; const float* w_down;
    float* out; unsigned char* ws;
};

__device__ __forceinline__ void p0_ada(const Args& a, LAS float* ldsf) {
    const int tid = tid_fresh();
    for (int i = tid; i < NB * DM; i += NTHR) ldsf[i] = silu_f(a.c[i]);
    __syncthreads();
    float* part = (float*)(a.ws + WS_PART);
    LAS float* red = ldsf + NB * DM;
    const int l16 = tid & 15, rg = tid >> 4;
    for (int it = blockIdx.x; it < 768; it += gridDim.x) {
        const int cgp = it % 192, kq = it / 192;
        const int e0 = cgp * 64 + 4 * l16, d0 = kq * 512 + rg * 16;
        f32x4 acc[4];
#pragma unroll
        for (int b = 0; b < 4; ++b) acc[b] = (f32x4){0.f, 0.f, 0.f, 0.f};
        f32x4 w[16];
#pragma unroll
        for (int i = 0; i < 16; ++i) w[i] = __builtin_nontemporal_load((const f32x4*)(a.w_ada + (size_t)(d0 + i) * MODW + e0));
#pragma unroll
        for (int i = 0; i < 16; ++i)
#pragma unroll
            for (int b = 0; b < 4; ++b) acc[b] += w[i] * ldsf[b * DM + d0 + i];
#pragma unroll
        for (int b = 0; b < 4; ++b) *(LAS f32x4*)(red + (rg * 4 + b) * 64 + 4 * l16) = acc[b];
        __syncthreads();
        if (tid < 256) { const int b = tid >> 6, col = tid & 63; float s = 0.f;
#pragma unroll 8
            for (int r = 0; r < 32; ++r) s += red[(r * 4 + b) * 64 + col];
            part[(size_t)(kq * 4 + b) * MODW + cgp * 64 + col] = s; }
        __syncthreads();
    }
}
__device__ __forceinline__ void conv_item(const float* W, int N, bf16_t* WT, int ldt, int mode, LAS float* scr, int item, int lane) {
    const int nblk = N / 64, kb = item / nblk, nb = item % nblk, k0 = 64 * kb, n0 = 64 * nb;
    const int l32 = lane & 31, lh = lane >> 5;
    f32x2 v[32];
#pragma unroll
    for (int i = 0; i < 32; ++i) v[i] = __builtin_nontemporal_load((const f32x2*)(W + (size_t)(k0 + 2 * i + lh) * N + n0 + 2 * l32));
#pragma unroll
    for (int i = 0; i < 32; ++i) { const int kk = 2 * i + lh; scr[kk * 65 + 2 * l32] = v[i].x; scr[kk * 65 + 2 * l32 + 1] = v[i].y; }
    asm volatile("s_waitcnt lgkmcnt(0)" ::: "memory");
    const int c = lane & 7;
#pragma unroll
    for (int j = 0; j < 8; ++j) { const int n = (lane >> 3) + 8 * j; const LAS float* s = scr + (8 * c) * 65 + n;
        u32x4 o; o.x = pk2(s[0 * 65], s[1 * 65]); o.y = pk2(s[2 * 65], s[3 * 65]); o.z = pk2(s[4 * 65], s[5 * 65]); o.w = pk2(s[6 * 65], s[7 * 65]);
        const int gn = n0 + n; int row;
        if (mode == 0) row = gn;
        else if (mode == 3) { row = gn < 2 * AW ? ((gn & ~127) + 32 * ((gn & 63) >> 4) + 16 * ((gn >> 6) & 1) + (gn & 15)) : gn;
                              if (gn >= AW && gn < 3 * AW) row += (gn < 2 * AW) ? AW : -AW; }
        else row = 32 * (gn >> 4) + (gn & 15) + (mode == 2 ? 16 : 0);
        *(u32x4*)(WT + (size_t)row * ldt + k0 + 8 * c) = o; }
    asm volatile("s_waitcnt lgkmcnt(0)" ::: "memory");
}
template <int PART>
__device__ __forceinline__ void p0_convert(const Args& a, LAS unsigned char* lds, int wg, int nwg, const float* wdown, const float* wup = nullptr) {
    const int tid = tid_fresh(), lane = tid & 63, wave = __builtin_amdgcn_readfirstlane(tid >> 6);
    LAS float* scr = (LAS float*)(lds + wave * 16640);
    const int gw = wg * NWAVES + wave, NGW = nwg * NWAVES;
    constexpr int I_IN = (DM / 64) * (INW / 64), I_OUT = (DM / 64) * (DM / 64), I_G = (DM / 64) * (DFF / 64), I_D = (DFF / 64) * (DM / 64), I_P = 16;
    if (PART == 1) { for (int it = gw; it < I_D; it += NGW) conv_item(wdown, DM, (bf16_t*)(a.ws + WS_WDN), DFF, 0, scr, it, lane); return; }
    if (PART == 2) { bf16_t* wgu = (bf16_t*)(a.ws + WS_WGU);
        for (int it = gw; it < 2 * I_G; it += NGW) { if (it < I_G) conv_item(wdown, DFF, wgu, DM, 1, scr, it, lane); else conv_item(wup, DFF, wgu, DM, 2, scr, it - I_G, lane); } return; }
    constexpr int NIT = I_IN + I_OUT + 4 * I_P;
    for (int it = gw; it < NIT; it += NGW) {
        int r = it;
        if (r < I_IN) { conv_item(a.w_in, INW, (bf16_t*)(a.ws + WS_WIN), DM, 3, scr, r, lane); continue; } r -= I_IN;
        if (r < I_OUT) { conv_item(a.w_out, DM, (bf16_t*)(a.ws + WS_WOUT), DM, 0, scr, r, lane); continue; } r -= I_OUT;
        const int g = r / I_P; r -= g * I_P;
        conv_item(a.w_pool + (size_t)g * 65536, 256, (bf16_t*)(a.ws + WS_WPOOL) + (size_t)g * 65536, 256, 0, scr, r, lane);
    }
}

template <bool FROM_PART>
__device__ __forceinline__ void norm_phase(const Args& a, const float* X, const float* g, int sh_idx, int sc_idx, bf16_t* OUT, LAS float* ldsf) {
    const int tid = tid_fresh(), lane = tid & 63, wave = tid >> 6;
    const float* part = (const float*)(a.ws + WS_PART);
    float* mod = (float*)(a.ws + WS_MOD);
    if (FROM_PART) {
        for (int i = blockIdx.x * NTHR + tid; i < NB * MODW; i += gridDim.x * NTHR) { const int b = i / MODW, e = i % MODW;
            float s = a.b_ada[e];
#pragma unroll
            for (int kq = 0; kq < 4; ++kq) s += part[(size_t)(kq * 4 + b) * MODW + e];
            mod[i] = s; }
    }
    LAS float* sa = ldsf; LAS float* ss = ldsf + DM;
    int cur_b = -1;
    const float invf = (float)exp2(-(double)(tid & 63) * (13.287712379549449 / 64.0));
    for (int rb = blockIdx.x; rb < MTOK / 32; rb += gridDim.x) {
        const int b = rb / (SEQ / 32);
        if (FROM_PART) {
            float* ct = (float*)(a.ws + WS_COS) + (size_t)rb * 32 * 64; float* st = (float*)(a.ws + WS_SIN) + (size_t)rb * 32 * 64;
#pragma unroll
            for (int k = 0; k < 4; ++k) { const int idx = tid + NTHR * k; const float ang = (float)a.pos[rb * 32 + (idx >> 6)] * invf; float sn, cs; sincosf(ang, &sn, &cs); ct[idx] = cs; st[idx] = sn; }
        }
        if (b != cur_b) {
            __syncthreads();
            for (int d = tid; d < DM; d += NTHR) {
                float sc, sh;
                if (FROM_PART) { sc = a.b_ada[sc_idx * DM + d]; sh = a.b_ada[sh_idx * DM + d];
#pragma unroll
                    for (int kq = 0; kq < 4; ++kq) { sc += part[(size_t)(kq * 4 + b) * MODW + sc_idx * DM + d]; sh += part[(size_t)(kq * 4 + b) * MODW + sh_idx * DM + d]; } }
                else { sc = mod[(size_t)b * MODW + sc_idx * DM + d]; sh = mod[(size_t)b * MODW + sh_idx * DM + d]; }
                sa[d] = g[d] * (1.0f + sc); ss[d] = sh; }
            __syncthreads();
            cur_b = b;
        }
#pragma unroll 1
        for (int i = 0; i < 4; ++i) {
            const int row = rb * 32 + wave * 4 + i;
            const f32x4* xr = (const f32x4*)(X + (size_t)row * DM) + lane;
            f32x4 v[8]; float s = 0.f;
#pragma unroll
            for (int j = 0; j < 8; ++j) { v[j] = __builtin_nontemporal_load(xr + 64 * j); s += (v[j].x * v[j].x + v[j].y * v[j].y) + (v[j].z * v[j].z + v[j].w * v[j].w); }
            const float rstd = 1.0f / sqrtf(wave_sum(s, lane) * (1.0f / DM) + EPS);
            u32x2* op = (u32x2*)(OUT + (size_t)row * DM) + lane;
#pragma unroll
            for (int j = 0; j < 8; ++j) { const int d = 4 * (lane + 64 * j); const f32x4 av = *(const LAS f32x4*)(sa + d), sv = *(const LAS f32x4*)(ss + d);
                const f32x4 o = v[j] * rstd * av + sv; u32x2 w; w.x = pk2(o[0], o[1]); w.y = pk2(o[2], o[3]); op[64 * j] = w; }
        }
    }
    __syncthreads();
}

__device__ __forceinline__ f32x4 ld_bf4(const bf16_t* p) { const u32x2 w = __builtin_nontemporal_load((const u32x2*)p); return (f32x4){__builtin_bit_cast(float, w.x << 16), __builtin_bit_cast(float, w.x & 0xffff0000u), __builtin_bit_cast(float, w.y << 16), __builtin_bit_cast(float, w.y & 0xffff0000u)}; }
template <int W>
__device__ __forceinline__ void p3_pool(const bf16_t* zc, bf16_t* pb, int s0) {
    f32x4 prev[W - 1], u[16];
#pragma unroll
    for (int j = 0; j < W - 1; ++j) { const int k = (W - 1) - j; prev[j] = (s0 - k >= 0) ? ld_bf4(zc - (long)k * INW) : (f32x4){0.f, 0.f, 0.f, 0.f}; }
#pragma unroll
    for (int i = 0; i < 16; ++i) u[i] = ld_bf4(zc + (size_t)i * INW);
    f32x4 acc = (f32x4){0.f, 0.f, 0.f, 0.f};
#pragma unroll
    for (int j = 0; j < W - 1; ++j) acc += prev[j];
#pragma unroll
    for (int i = 0; i < 16; ++i) {
        const int t = s0 + i;
        acc += u[i];
        const float inv = 1.0f / (float)(t + 1 < W ? t + 1 : W);
        const f32x4 o = acc * inv - u[i];
        u32x2 w; w.x = pk2(o[0], o[1]); w.y = pk2(o[2], o[3]); *(u32x2*)(pb + (size_t)i * PW) = w;
        acc -= (i - W + 1 >= 0) ? u[(i - W + 1 >= 0) ? i - W + 1 : 0] : prev[(i < W - 1) ? i : 0];
    }
}
__device__ __forceinline__ void p3_unit(const Args& a, int rb, int cgi, LAS float* ldsf) {
    const int tid = tid_fresh(), lane = tid & 63, wave = tid >> 6;
    const bf16_t* Z = (const bf16_t*)(a.ws + WS_ZF);
    const int b = rb >> 3, sblk = rb & 7;
    const int row0 = rb * 256 + wave * 32, s0 = sblk * 256 + wave * 32;
    if (cgi < 16) {
        const int head = cgi & 7; const bool isK = cgi >= 8;
        const float* gg = isK ? a.g_k : a.g_q;
        const int sub = lane >> 4, d0 = 4 * (lane & 15);
        const f32x4 g0 = *(const f32x4*)(gg + d0), g1 = *(const f32x4*)(gg + 64 + d0);
        bf16_t* dst = (bf16_t*)(a.ws + (isK ? WS_K : WS_Q)) + ((size_t)(b * NH + head) * SEQ + s0 + sub) * HD + d0;
        const bf16_t* zp = Z + (size_t)(row0 + sub) * INW + cgi * 128 + d0;
        const float* ct = (const float*)(a.ws + WS_COS) + (size_t)(row0 + sub) * 64 + d0;
        const float* st = (const float*)(a.ws + WS_SIN) + (size_t)(row0 + sub) * 64 + d0;
        f32x4 km0 = (f32x4){0.f, 0.f, 0.f, 0.f}, km1 = (f32x4){0.f, 0.f, 0.f, 0.f};
#pragma unroll 4
        for (int p = 0; p < 8; ++p) {
            const f32x4 x0 = ld_bf4(zp + (size_t)(4 * p) * INW), x1 = ld_bf4(zp + (size_t)(4 * p) * INW + 64);
            const f32x4 cs = *(const f32x4*)(ct + (size_t)(4 * p) * 64), sn = *(const f32x4*)(st + (size_t)(4 * p) * 64);
            float ssq = (x0[0] * x0[0] + x0[1] * x0[1]) + (x0[2] * x0[2] + x0[3] * x0[3]) + (x1[0] * x1[0] + x1[1] * x1[1]) + (x1[2] * x1[2] + x1[3] * x1[3]);
            ssq += swz_xor<1>(ssq); ssq += swz_xor<2>(ssq); ssq += swz_xor<4>(ssq); ssq += swz_xor<8>(ssq);
            const float rstd = 1.0f / sqrtf(ssq * (1.0f / HD) + EPS);
            const f32x4 n0 = x0 * rstd * g0, n1 = x1 * rstd * g1;
            const f32x4 o0 = n0 * cs - n1 * sn, o1 = n1 * cs + n0 * sn;
            u32x2 w0, w1; w0.x = pk2(o0[0], o0[1]); w0.y = pk2(o0[2], o0[3]); w1.x = pk2(o1[0], o1[1]); w1.y = pk2(o1[2], o1[3]);
            *(u32x2*)(dst + (size_t)(4 * p) * HD) = w0; *(u32x2*)(dst + (size_t)(4 * p) * HD + 64) = w1;
            km0 += o0; km1 += o1;
        }
        if (isK) {
#pragma unroll
            for (int j = 0; j < 4; ++j) { km0[j] += swz_xor<16>(km0[j]); km0[j] = add_x32(km0[j], lane); km1[j] += swz_xor<16>(km1[j]); km1[j] = add_x32(km1[j], lane); }
            if (sub == 0) { *(LAS f32x4*)(ldsf + wave * 128 + d0) = km0; *(LAS f32x4*)(ldsf + wave * 128 + 64 + d0) = km1; }
            __syncthreads();
            if (tid < 128) { float s = 0.f;
#pragma unroll
                for (int w = 0; w < 8; ++w) s += ldsf[w * 128 + tid];
                ((float*)(a.ws + WS_KMEAN))[((size_t)(b * NH + head) * NBLK + sblk) * HD + tid] = s * (1.0f / MBLK); }
            __syncthreads();
        }
    } else {
        const int uc0 = (cgi - 24) * 128, grp = (cgi - 24) >> 1;
        const int hrow = 16 * (lane >> 5), c4 = 4 * (lane & 31);
        const bf16_t* zc = Z + (size_t)(row0 + hrow) * INW + 3 * AW + uc0 + c4;
        bf16_t* pb = (bf16_t*)(a.ws + WS_PB) + (size_t)(row0 + hrow) * PW + uc0 + c4;
        if (grp == 0) p3_pool<2>(zc, pb, s0 + hrow); else if (grp == 1) p3_pool<4>(zc, pb, s0 + hrow); else if (grp == 2) p3_pool<8>(zc, pb, s0 + hrow); else p3_pool<16>(zc, pb, s0 + hrow);
    }
}

constexpr int AT_NS = 4, AT_SLOT = 32768, AT_KM = AT_NS * AT_SLOT;
typedef short v4i16_t __attribute__((ext_vector_type(4)));
__device__ __forceinline__ void glds16(const void* gsrc, unsigned lds_dst) { unsigned keep;
    asm volatile("s_mov_b32 %0, m0\n\ts_mov_b32 m0, %2\n\ts_nop 0\n\tglobal_load_lds_dwordx4 %1, off\n\ts_mov_b32 m0, %0" : "=&s"(keep) : "v"(gsrc), "s"(lds_dst) : "memory"); }
__device__ __forceinline__ void attn_unit(const Args& a, int bh, int qb, int half, LAS unsigned char* lds) {
    const int tid = tid_fresh(), lane = tid & 63, wave = __builtin_amdgcn_readfirstlane(tid >> 6), r = lane & 15, q4 = lane >> 4;
    const int qrow0 = half * 128 + wave * 16;
    const bf16_t* Qg = (const bf16_t*)(a.ws + WS_Q) + ((size_t)bh * SEQ + qb * MBLK + qrow0) * HD;
    const bf16_t* Kg = (const bf16_t*)(a.ws + WS_K) + (size_t)bh * SEQ * HD;
    const bf16_t* Vg = (const bf16_t*)(a.ws + WS_VT) + (size_t)bh * SEQ * HD;
    const float* KM = (const float*)(a.ws + WS_KMEAN) + (size_t)bh * NBLK * HD;
    LAS float* kml = (LAS float*)(lds + AT_KM);
    asm volatile("s_waitcnt vmcnt(0)" ::: "memory");
    for (int i = tid; i < qb * HD; i += NTHR) kml[i] = KM[i];
    bf16x8 Qf[4];
#pragma unroll
    for (int kk = 0; kk < 4; ++kk) Qf[kk] = __builtin_nontemporal_load((const bf16x8*)(Qg + (size_t)r * HD + 32 * kk + 8 * q4));
    const int nown = half ? 4 : 2, NT = nown + 4 * qb;
    unsigned koff[2], voff[2];
#pragma unroll
    for (int i = 0; i < 2; ++i) { const int row = 4 * (2 * wave + i) + (lane >> 4), pc = lane & 15;
        koff[i] = (unsigned)(row * HD + ((pc ^ (row & 15)) * 8)) * 2u;
        voff[i] = (unsigned)(row * HD + ((pc ^ (((row & 3) << 2) | ((row >> 2) & 3))) * 8)) * 2u; }
#define AT_ISSUE(t) do { const int own_ = (t) < nown; const int blk_ = own_ ? qb : (((t) - nown) >> 2), T_ = own_ ? (t) : (((t) - nown) & 3); const size_t gb_ = (size_t)(blk_ * MBLK + 64 * T_) * HD * 2; \
        const unsigned sl_ = (unsigned)__builtin_amdgcn_readfirstlane((int)(lds0 + ((t) & 3) * AT_SLOT + wave * 2048)); \
        _Pragma("unroll") for (int i_ = 0; i_ < 2; ++i_) { \
            glds16((const char*)Kg + gb_ + koff[i_], sl_ + i_ * 1024); \
            glds16((const char*)Vg + gb_ + voff[i_], sl_ + 16384 + i_ * 1024); } } while (0)
    const unsigned lds0 = (unsigned)(size_t)lds;
    AT_ISSUE(0); if (NT > 1) AT_ISSUE(1); if (NT > 2) AT_ISSUE(2);
    __syncthreads();
    unsigned sel;
    {
        float gate[7];
#pragma unroll
        for (int j = 0; j < 7; ++j) {
            float gsum = -INFINITY;
            if (j < qb) { float s = 0.f;
#pragma unroll
                for (int kk = 0; kk < 4; ++kk) { const f32x4 k0 = *(const LAS f32x4*)(kml + j * HD + 32 * kk + 8 * q4), k1 = *(const LAS f32x4*)(kml + j * HD + 32 * kk + 8 * q4 + 4);
                    const bf16x8 qv = Qf[kk];
                    s += bf2f((unsigned short)qv[0]) * k0[0] + bf2f((unsigned short)qv[1]) * k0[1] + bf2f((unsigned short)qv[2]) * k0[2] + bf2f((unsigned short)qv[3]) * k0[3]
                       + bf2f((unsigned short)qv[4]) * k1[0] + bf2f((unsigned short)qv[5]) * k1[1] + bf2f((unsigned short)qv[6]) * k1[2] + bf2f((unsigned short)qv[7]) * k1[3]; }
                s += swz_xor<16>(s); s = add_x32(s, lane); gsum = s; }
            gate[j] = gsum;
        }
        unsigned m = 0u;
#pragma unroll
        for (int j = 0; j < 7; ++j) { int cnt = 0;
#pragma unroll
            for (int i = 0; i < 7; ++i) if (i != j) cnt += (gate[i] > gate[j] || (gate[i] == gate[j] && i < j)) ? 1 : 0;
            if (cnt < 3) m |= 1u << j; }
        sel = m & ((1u << qb) - 1u);
    }
    f32x4 o[8];
#pragma unroll
    for (int dt = 0; dt < 8; ++dt) o[dt] = (f32x4){0.f, 0.f, 0.f, 0.f};
    float mref = -INFINITY, lrun = 0.f;
    constexpr float SC = 0.08838834764831845f * 1.4426950408889634f;
    constexpr float THR = 8.0f;
    const int qi = qrow0 + r;
    const int pir = 8 * ((r >> 2) & 1) + 4 * (r >> 3) + (r & 3);
    const int kbase_g = 8 * (q4 & 1) + 4 * (q4 >> 1);
    int kaddr[4];
#pragma unroll
    for (int kk = 0; kk < 4; ++kk) kaddr[kk] = pir * 256 + (((4 * kk + q4) ^ pir) * 16);
    const int fg = (2 * (q4 & 1) + (q4 >> 1)) & 3, vq = r >> 2, vp = r & 3;
    int vaddr[8];
#pragma unroll
    for (int dt = 0; dt < 8; ++dt) vaddr[dt] = 16384 + (kbase_g + vq) * 256 + (((2 * dt + (vp >> 1)) ^ ((vq << 2) | fg)) * 16) + 8 * (vp & 1);
    for (int t = 0; t < NT; ++t) {
        if (t + 2 < NT) asm volatile("s_waitcnt vmcnt(8)" ::: "memory"); else if (t + 1 < NT) asm volatile("s_waitcnt vmcnt(4)" ::: "memory"); else asm volatile("s_waitcnt vmcnt(0)" ::: "memory");
        __builtin_amdgcn_s_barrier(); asm volatile("" ::: "memory");
        if (t + 3 < NT) AT_ISSUE(t + 3);
        const bool own = t < nown; const int blk = own ? qb : ((t - nown) >> 2), T = own ? t : ((t - nown) & 3);
        const bool lsel = own ? true : ((sel >> blk) & 1u) != 0u;
        const bool active = own ? (64 * T <= qrow0 + 15) : (__any((int)lsel) != 0);
        if (active) {
            const LAS unsigned char* sl = lds + (t & 3) * AT_SLOT;
            f32x4 s[4];
            bf16x8 kf[4][4];
#pragma unroll
            for (int kk = 0; kk < 4; ++kk)
#pragma unroll
                for (int kt = 0; kt < 4; ++kt) kf[kk][kt] = *(const LAS bf16x8*)(sl + kaddr[kk] + kt * 4096);
            __builtin_amdgcn_sched_barrier(0);
#pragma unroll
            for (int kt = 0; kt < 4; ++kt) s[kt] = (f32x4){0.f, 0.f, 0.f, 0.f};
#pragma unroll
            for (int kk = 0; kk < 4; ++kk)
#pragma unroll
                for (int kt = 0; kt < 4; ++kt) s[kt] = __builtin_amdgcn_mfma_f32_16x16x32_bf16(kf[kk][kt], Qf[kk], s[kt], 0, 0, 0);
            v4i16_t vlo[2][8], vhi[2][8];
#pragma unroll
            for (int dt = 0; dt < 8; ++dt) { vlo[0][dt] = __builtin_amdgcn_ds_read_tr16_b64_v4i16((LAS v4i16_t*)(sl + vaddr[dt])); vhi[0][dt] = __builtin_amdgcn_ds_read_tr16_b64_v4i16((LAS v4i16_t*)(sl + vaddr[dt] + 4096)); }
            __builtin_amdgcn_sched_barrier(0);
            if (own && 64 * T + 63 > qrow0) {
#pragma unroll
                for (int kt = 0; kt < 4; ++kt)
#pragma unroll
                    for (int j = 0; j < 4; ++j) if (64 * T + 16 * kt + kbase_g + j > qi) s[kt][j] = -INFINITY; }
            float mx = max3f(s[0][0], s[0][1], s[0][2]);
            mx = max3f(mx, s[0][3], s[1][0]); mx = max3f(mx, s[1][1], s[1][2]); mx = max3f(mx, s[1][3], s[2][0]); mx = max3f(mx, s[2][1], s[2][2]);
            mx = max3f(mx, s[2][3], s[3][0]); mx = max3f(mx, s[3][1], s[3][2]); mx = fmaxf(mx, s[3][3]);
            mx = lsel ? mx : -INFINITY;
            mx = fmaxf(mx, swz_xor<16>(mx)); mx = max_x32(mx, lane);
            mx *= SC;
            if (__any((int)(mx > mref + THR))) {
                const float mnew = fmaxf(mref, mx); const float alpha = __builtin_amdgcn_exp2f(mref - mnew);
                mref = mnew; lrun *= alpha;
#pragma unroll
                for (int dt = 0; dt < 8; ++dt) o[dt] *= alpha;
            }
            const float negm = lsel ? -mref : -INFINITY;
            const f32x2 negm2 = {negm, negm}, sc2 = {SC, SC};
            f32x2 ps2 = {0.f, 0.f};
            unsigned pw[8];
#pragma unroll
            for (int kt = 0; kt < 4; ++kt)
#pragma unroll
                for (int h = 0; h < 2; ++h) { f32x2 v = {s[kt][2 * h], s[kt][2 * h + 1]}; v = v * sc2 + negm2;
                    f32x2 p; p.x = __builtin_amdgcn_exp2f(v.x); p.y = __builtin_amdgcn_exp2f(v.y); ps2 += p; pw[2 * kt + h] = pk2(p.x, p.y); }
            lrun += ps2.x + ps2.y;
            bf16x8 P[2];
#pragma unroll
            for (int c = 0; c < 2; ++c) { u32x4 w; w.x = pw[4 * c]; w.y = pw[4 * c + 1]; w.z = pw[4 * c + 2]; w.w = pw[4 * c + 3]; P[c] = __builtin_bit_cast(bf16x8, w); }
            __builtin_amdgcn_sched_barrier(0);
#pragma unroll
            for (int dt = 0; dt < 8; ++dt) { vlo[1][dt] = __builtin_amdgcn_ds_read_tr16_b64_v4i16((LAS v4i16_t*)(sl + vaddr[dt] + 8192)); vhi[1][dt] = __builtin_amdgcn_ds_read_tr16_b64_v4i16((LAS v4i16_t*)(sl + vaddr[dt] + 8192 + 4096)); }
            __builtin_amdgcn_sched_barrier(0);
#pragma unroll
            for (int c = 0; c < 2; ++c) {
#pragma unroll
                for (int dt = 0; dt < 8; ++dt) { const v4i16_t lo = vlo[c][dt], hi = vhi[c][dt];
                    const bf16x8 vf = (bf16x8){lo[0], lo[1], lo[2], lo[3], hi[0], hi[1], hi[2], hi[3]};
                    o[dt] = __builtin_amdgcn_mfma_f32_16x16x32_bf16(vf, P[c], o[dt], 0, 0, 0); }
                __builtin_amdgcn_sched_barrier(0);
            }
        }
    }
    asm volatile("s_waitcnt lgkmcnt(0)" ::: "memory");
    __builtin_amdgcn_s_barrier(); asm volatile("" ::: "memory");
#undef AT_ISSUE
    const int b = bh >> 3, h = bh & 7;
    float l = lrun; l += swz_xor<16>(l); l = add_x32(l, lane);
    const float il = 1.0f / l;
    bf16_t* op = (bf16_t*)(a.ws + WS_OC) + ((size_t)b * SEQ + qb * MBLK + qi) * DM + h * HD + 4 * q4;
#pragma unroll
    for (int dt = 0; dt < 8; ++dt) { const f32x4 v = o[dt] * il; u32x2 w; w.x = pk2(v[0], v[1]); w.y = pk2(v[2], v[3]); *(u32x2*)(op + 16 * dt) = w; }
}

#define XB_TMO      128
#define XB_XCNT(j)  (256  + 64 * (j))
#define XB_XSUB(j)  (1280 + 64 * (j))
#define XB_XGEN(j)  (2304 + 64 * (j))
#define XB_TOP      3328
#define XB_TOPGEN   3392
#define XCD_BAR_WORDS 3456
#define XB_SPIN_CAP (1u << 18)
__device__ __forceinline__ unsigned xb_ld(unsigned* p)              { return __hip_atomic_load(p, __ATOMIC_RELAXED, __HIP_MEMORY_SCOPE_AGENT); }
__device__ __forceinline__ unsigned xb_add(unsigned* p, unsigned v) { return __hip_atomic_fetch_add(p, v, __ATOMIC_RELAXED, __HIP_MEMORY_SCOPE_AGENT); }
__device__ __forceinline__ unsigned xb_xcc_id() { return (unsigned)__builtin_amdgcn_s_getreg((3 << 11) | 20) & 0xFu; }
#define XB_SPIN(cond, bar) do { unsigned _sp = 0; while (cond) { __builtin_amdgcn_s_sleep(1); \
    if ((++_sp & 255u) == 0u) { if (xb_ld(&(bar)[XB_TMO])) break; if (_sp > XB_SPIN_CAP) { atomicAdd(&(bar)[XB_TMO], 1u); break; } } } } while (0)
struct XcdBarrier { unsigned* bar; unsigned x; volatile LAS unsigned* st; };
__device__ __forceinline__ XcdBarrier xcd_barrier_post(unsigned* bar, volatile LAS unsigned* st) {
    XcdBarrier b; b.bar = bar; b.x = xb_xcc_id(); b.st = st;
    if (threadIdx.x == 0) (void)xb_add(&bar[XB_XCNT(b.x)], 1u);
    return b;
}
__device__ __forceinline__ void xcd_barrier_complete(unsigned* bar, unsigned x, unsigned& nloc, unsigned& nx) {
    const unsigned G = gridDim.x * gridDim.y * gridDim.z;
    unsigned sum, cnt, mine, sp = 0u;
    for (;;) {
        sum = 0u; cnt = 0u; mine = 0u;
#pragma unroll
        for (unsigned j = 0; j < 16; ++j) { const unsigned c = xb_ld(&bar[XB_XCNT(j)]); sum += c; cnt += (c > 0u) ? 1u : 0u; mine = (j == x) ? c : mine; }
        if (sum == G) break;
        __builtin_amdgcn_s_sleep(1);
        if ((++sp & 255u) == 0u) { if (xb_ld(&bar[XB_TMO])) break; if (sp > XB_SPIN_CAP) { atomicAdd(&bar[XB_TMO], 1u); break; } }
    }
    nloc = mine > 0u ? mine : 1u; nx = cnt > 0u ? cnt : 1u;
}
__device__ __forceinline__ void xcd_barrier(const XcdBarrier& b) {
    asm volatile("s_waitcnt vmcnt(0)" ::: "memory");
    __syncthreads();
    if (threadIdx.x == 0) {
        unsigned* bar = b.bar;
        const unsigned bx_ = xb_xcc_id();
        __builtin_amdgcn_s_waitcnt(0);
        unsigned nloc = b.st[0], nx = b.st[1];
        if (nloc == 0u) { xcd_barrier_complete(bar, bx_, nloc, nx); b.st[0] = nloc; b.st[1] = nx; }
        const unsigned old = xb_add(&bar[XB_XSUB(bx_)], 1u);
        const unsigned gen = old / nloc;
        if (old + 1u == (gen + 1u) * nloc) {
            __builtin_amdgcn_fence(__ATOMIC_RELEASE, "agent");
            asm volatile("s_waitcnt vmcnt(0)" ::: "memory");
            const unsigned og = xb_add(&bar[XB_TOP], 1u);
            const unsigned tg = og / nx;
            if (og + 1u == (tg + 1u) * nx) xb_add(&bar[XB_TOPGEN], 1u);
            else XB_SPIN(xb_ld(&bar[XB_TOPGEN]) == tg, bar);
            __builtin_amdgcn_fence(__ATOMIC_ACQUIRE, "agent");
            xb_add(&bar[XB_XGEN(bx_)], 1u);
            asm volatile("s_waitcnt vmcnt(0)" ::: "memory");
        } else {
            XB_SPIN(xb_ld(&bar[XB_XGEN(bx_)]) == gen, bar);
            __builtin_amdgcn_fence(__ATOMIC_ACQUIRE, "agent");
            asm volatile("s_waitcnt vmcnt(0)" ::: "memory");
        }
    }
    __syncthreads();
}

__global__ void __launch_bounds__(NTHR, 2) hymba_fwd(Args a) {
    extern __shared__ __attribute__((aligned(16))) unsigned char lds_raw[];
    LAS unsigned char* lds = (LAS unsigned char*)lds_raw;
    LAS float* ldsf = (LAS float*)lds_raw;
    cg::grid_group grid = cg::this_grid();
    const int G = gridDim.x, bx = blockIdx.x;
    unsigned char* ws = a.ws;
    volatile LAS unsigned* bst = (volatile LAS unsigned*)(lds + LDS_BYTES - 64);
    volatile LAS unsigned long long* stash = (volatile LAS unsigned long long*)(lds + LDS_BYTES - 128);
    if (threadIdx.x < 2) bst[threadIdx.x] = 0u;
    if (threadIdx.x == 0) { stash[0] = (unsigned long long)a.pool_scale; stash[1] = (unsigned long long)a.x; stash[2] = (unsigned long long)a.out; stash[3] = (unsigned long long)a.g_ffn; stash[4] = (unsigned long long)a.w_down; stash[5] = (unsigned long long)a.w_gate; stash[6] = (unsigned long long)a.w_up; }
    __syncthreads();
#define STASHED(T, i) ((T)(((unsigned long long)(unsigned)__builtin_amdgcn_readfirstlane((int)(stash[i] & 0xffffffffull))) | ((unsigned long long)(unsigned)__builtin_amdgcn_readfirstlane((int)(stash[i] >> 32)) << 32)))
    const XcdBarrier bar = xcd_barrier_post((unsigned*)(ws + WS_CTL), bst);
#define GRID_BAR() xcd_barrier(bar)
#ifndef DUPMASK
#define DUPMASK 0
#endif
#define REP(k) for (int rep_ = 0; rep_ < (((DUPMASK) >> (k)) & 1 ? 2 : 1); ++rep_)

    if (a.ws == nullptr) grid.sync();
    { p0_ada(a, ldsf);
    if ((DUPMASK) & 256) { __syncthreads(); p0_ada(a, ldsf); }
    p0_convert<0>(a, lds, bx, G, nullptr);
    if ((DUPMASK) & 512) { __syncthreads(); p0_convert<0>(a, lds, bx, G, nullptr); }
    GRID_BAR(); }
    REP(1) { norm_phase<true>(a, a.x, a.g_mix, 0, 1, (bf16_t*)(ws + WS_XN), ldsf);
    GRID_BAR(); }
    REP(2) { pg8::Gemm g{(const bf16_t*)(ws + WS_XN), (const bf16_t*)(ws + WS_WIN), MTOK, INW, DM, DM, DM}; pg8::StaticOrder S; S.init(MTOK, INW, G, bx);
      pg8::EpiF32 E{(bf16_t*)(ws + WS_ZF), INW, (bf16_t*)(ws + WS_VT), (bf16_t*)(ws + WS_Q), (bf16_t*)(ws + WS_K), (float*)(ws + WS_KMEAN), a.g_q, a.g_k, (const float*)(ws + WS_COS), (const float*)(ws + WS_SIN), (LAS float*)(lds + 131072)};
      pg8::gemm_phase<pg8::EpiF32, pg8::StaticOrder, true>(lds, g, S, E);
    GRID_BAR(); }
    REP(4) {
    const bool gu_early = ((bx >> 3) & 1) == 0;
    if (rep_ == 0 && gu_early) { p0_convert<2>(a, lds, bx, G, STASHED(const float*, 5), STASHED(const float*, 6)); __syncthreads(); }
    for (int u = bx; u < 256; u += G) {
        const int x = u & 7, i = u >> 3, s2 = i >> 4, j = i & 15, qb = j >> 1, hf = j & 1;
        attn_unit(a, x + 8 * s2, qb, hf, lds); __syncthreads();
        attn_unit(a, x + 16 + 8 * s2, 7 - qb, 1 - hf, lds); __syncthreads(); }
    if (rep_ == 0 && !gu_early) { p0_convert<2>(a, lds, bx, G, STASHED(const float*, 5), STASHED(const float*, 6)); __syncthreads(); }
    for (int w = G - 1 - bx; w < 128; w += G) {
        const int grp = w >> 5, pm = w & 31;
        p3_unit(a, pm, 24 + 2 * grp, ldsf); p3_unit(a, pm, 25 + 2 * grp, ldsf);
        asm volatile("s_waitcnt vmcnt(0)" ::: "memory"); __syncthreads();
        pg8::Gemm g{(const bf16_t*)(ws + WS_PB) + grp * 256, (const bf16_t*)(ws + WS_WPOOL) + (size_t)grp * 65536, MTOK, 256, 256, PW, 256};
        pg8::OneUnit S{pm, 0, 1};
        pg8::EpiScaleBf16 E{(bf16_t*)(ws + WS_OC) + AW + grp * 256, DM, STASHED(const float*, 0) + grp * 256};
        pg8::gemm_phase<pg8::EpiScaleBf16, pg8::OneUnit, true>(lds, g, S, E);
    }
    if (rep_ == 0) { const float* wd = STASHED(const float*, 4);
        const int w = G - 1 - bx;
        if (G > 128) { if (w >= 128) p0_convert<1>(a, lds, w - 128, G - 128, wd); } else p0_convert<1>(a, lds, bx, G, wd); }
    GRID_BAR(); }
    if (G == 256) {
      REP(5) { pg8::Gemm g{(const bf16_t*)(ws + WS_OC), (const bf16_t*)(ws + WS_WOUT), MTOK, DM, DM, DM, DM}; pg8::StaticOrder S; S.init(MTOK, DM, G, bx);
      const float* mod = (const float*)(ws + WS_MOD);
      pg8::EpiGateResNorm E{STASHED(const float*, 1), STASHED(float*, 2), DM, mod + 2 * DM, STASHED(const float*, 3), mod + 4 * DM, mod + 3 * DM, MODW, (bf16_t*)(ws + WS_XN), (float*)(ws + WS_SLOTS), (unsigned*)(ws + WS_CTL) + CW_PANEL + rep_ * 2048};
      pg8::gemm_phase<pg8::EpiGateResNorm, pg8::StaticOrder, true>(lds, g, S, E);
      GRID_BAR(); }
    } else {
      { pg8::Gemm g{(const bf16_t*)(ws + WS_OC), (const bf16_t*)(ws + WS_WOUT), MTOK, DM, DM, DM, DM}; pg8::StaticOrder S; S.init(MTOK, DM, G, bx);
      pg8::EpiGateRes E{STASHED(const float*, 1), STASHED(float*, 2), DM, (const float*)(ws + WS_MOD) + 2 * DM, MODW};
      pg8::gemm_phase<pg8::EpiGateRes, pg8::StaticOrder, true>(lds, g, S, E);
      GRID_BAR(); }
      norm_phase<false>(a, STASHED(const float*, 2), STASHED(const float*, 3), 3, 4, (bf16_t*)(ws + WS_XN), ldsf);
      GRID_BAR();
    }
    REP(7) { pg8::Gemm g{(const bf16_t*)(ws + WS_XN), (const bf16_t*)(ws + WS_WGU), MTOK, 2 * DFF, DM, DM, DM}; pg8::StaticOrder S; S.init(MTOK, 2 * DFF, G, bx);
      const bool tail = (G == 256);
      if (tail) S.lim = (S.nwg / G) * G;
      { pg8::EpiSwiGLU E{(bf16_t*)(ws + WS_ZF), DFF, -1};
        pg8::gemm_phase<pg8::EpiSwiGLU, pg8::StaticOrder, true>(lds, g, S, E); }
      if (tail) {
          pg8::Unit tu; const int hw = bx >> 7;
          const bool has = S.at(S.lim + (bx & 127), tu);
          pg8::OneUnit S1{tu.pm, tu.pn, has ? 1 : 0};
          pg8::EpiSwiGLU E{(bf16_t*)(ws + WS_ZF), DFF, hw};
          if (hw == 0) pg8::gemm_phase<pg8::EpiSwiGLU, pg8::OneUnit, true, 0>(lds, g, S1, E); else pg8::gemm_phase<pg8::EpiSwiGLU, pg8::OneUnit, true, 1>(lds, g, S1, E);
      }
    GRID_BAR(); }
    { pg8::Gemm g{(const bf16_t*)(ws + WS_ZF), (const bf16_t*)(ws + WS_WDN), MTOK, DM, DFF, DFF, DFF}; pg8::StaticOrder S; S.init(MTOK, DM, G, bx);
      float* outp = STASHED(float*, 2);
      pg8::EpiGateRes E{outp, outp, DM, (const float*)(ws + WS_MOD) + 5 * DM, MODW};
      pg8::gemm_phase<pg8::EpiGateRes, pg8::StaticOrder, true>(lds, g, S, E); }
}

extern "C" void kernel_launch(void* const* d_in, const int* in_sizes, int n_in, void* d_out, int out_size, void* d_ws, size_t ws_size, hipStream_t stream) {
    static int grid = 0;
    if (grid == 0) {
        if (n_in != 16 || out_size != MTOK * DM || ws_size < WS_END) { fprintf(stderr, "kernel_launch: unexpected problem (n_in %d, out %d, ws %zu)\n", n_in, out_size, ws_size); grid = -1; return; }
        int dev = 0, cus = 0, per_cu = 0;
        hipGetDevice(&dev);
        hipDeviceGetAttribute(&cus, hipDeviceAttributeMultiprocessorCount, dev);
        if (hipFuncSetAttribute((const void*)hymba_fwd, hipFuncAttributeMaxDynamicSharedMemorySize, LDS_BYTES) != hipSuccess) { fprintf(stderr, "kernel_launch: hipFuncSetAttribute failed\n"); grid = -1; return; }
        if (hipOccupancyMaxActiveBlocksPerMultiprocessor(&per_cu, (const void*)hymba_fwd, NTHR, LDS_BYTES) != hipSuccess || per_cu < 1) { fprintf(stderr, "kernel_launch: occupancy query gave %d\n", per_cu); per_cu = 1; }
        (void)hipGetLastError();
        grid = cus * per_cu;
    }
    if (grid < 0) return;
    Args a{};
    a.x = (const float*)d_in[0]; a.c = (const float*)d_in[1]; a.pos = (const int*)d_in[2]; a.w_ada = (const float*)d_in[3]; a.b_ada = (const float*)d_in[4];
    a.g_mix = (const float*)d_in[5]; a.w_in = (const float*)d_in[6]; a.g_q = (const float*)d_in[7]; a.g_k = (const float*)d_in[8]; a.w_pool = (const float*)d_in[9];
    a.pool_scale = (const float*)d_in[10]; a.w_out = (const float*)d_in[11]; a.g_ffn = (const float*)d_in[12]; a.w_gate = (const float*)d_in[13]; a.w_up = (const float*)d_in[14];
    a.w_down = (const float*)d_in[15]; a.out = (float*)d_out; a.ws = (unsigned char*)d_ws;
    if (hipMemsetAsync((char*)d_ws + WS_CTL, 0, CTL_ZERO_BYTES, stream) != hipSuccess) { fprintf(stderr, "kernel_launch: memset of control words failed\n"); return; }
    void* args[] = {&a};
    hipError_t e = hipLaunchCooperativeKernel((const void*)hymba_fwd, dim3(grid), dim3(NTHR), args, LDS_BYTES, stream);
    if (e != hipSuccess) fprintf(stderr, "kernel_launch: cooperative launch failed: %s (grid %d)\n", hipGetErrorString(e), grid);
}
```

```cpp
#include <hip/hip_runtime.h>
#include <hip/hip_cooperative_groups.h>
#include <cstdio>
#include <cstdint>
#include <cmath>
namespace cg = cooperative_groups;

#define LAS __attribute__((address_space(3)))
typedef unsigned short bf16_t;
typedef short bf16x8 __attribute__((ext_vector_type(8)));
typedef short s16x4 __attribute__((ext_vector_type(4)));
typedef float f32x4 __attribute__((ext_vector_type(4)));
typedef float f32x2 __attribute__((ext_vector_type(2)));
typedef unsigned u32x4 __attribute__((ext_vector_type(4)));
typedef unsigned u32x2 __attribute__((ext_vector_type(2)));

constexpr int DM = 2048, NB = 4, SEQ = 2048, MTOK = NB * SEQ;
constexpr int NH = 8, HD = 128, AW = 1024, PW = 1024, INW = 4096, DFF = 5632, NMOD = 6, MODW = NMOD * DM;
constexpr int MBLK = 256, NBLK = SEQ / MBLK;
constexpr float EPS = 1e-6f;
constexpr int NTHR = 512, NWAVES = 8;

constexpr size_t MiB = 1u << 20;
constexpr size_t WS_CTL = 0, CTL_ZERO_BYTES = 65536;
constexpr size_t WS_SLOTS = 512 * 1024;
constexpr int CW_PANEL = 4096;
constexpr size_t WS_PART = 1 * MiB;
constexpr size_t WS_MOD = 2 * MiB;
constexpr size_t WS_KMEAN = 3 * MiB;
constexpr size_t WS_WIN = 4 * MiB;
constexpr size_t WS_WOUT = 20 * MiB;
constexpr size_t WS_WGU = 28 * MiB;
constexpr size_t WS_WDN = 72 * MiB;
constexpr size_t WS_WPOOL = 94 * MiB;
constexpr size_t WS_XN = 96 * MiB;
constexpr size_t WS_ZF = 128 * MiB;
constexpr size_t WS_Q = 256 * MiB;
constexpr size_t WS_K = 272 * MiB;
constexpr size_t WS_VT = 288 * MiB;
constexpr size_t WS_PB = 304 * MiB;
constexpr size_t WS_OC = 320 * MiB;
constexpr size_t WS_COS = 352 * MiB;
constexpr size_t WS_SIN = 354 * MiB;
constexpr size_t WS_END = 356 * MiB;

constexpr int LDS_BYTES = 147456;

__device__ __forceinline__ unsigned f2bf(float f) { unsigned u = __builtin_bit_cast(unsigned, f); return (u + 0x7fffu + ((u >> 16) & 1u)) >> 16; }
typedef __bf16 bf16x2_hw __attribute__((ext_vector_type(2)));
__device__ __forceinline__ unsigned pk2(float lo, float hi) { f32x2 v = {lo, hi}; bf16x2_hw b = __builtin_convertvector(v, bf16x2_hw); return __builtin_bit_cast(unsigned, b); }
__device__ __forceinline__ float bf2f(unsigned short h) { return __builtin_bit_cast(float, (unsigned)h << 16); }
template <int M> __device__ __forceinline__ float swz_xor(float v) { return __builtin_bit_cast(float, __builtin_amdgcn_ds_swizzle(__builtin_bit_cast(int, v), (M << 10) | 0x1f)); }
__device__ __forceinline__ float get_x32(float v, int lane) { return __builtin_bit_cast(float, __builtin_amdgcn_ds_bpermute((lane ^ 32) << 2, __builtin_bit_cast(int, v))); }
__device__ __forceinline__ float add_x32(float v, int lane) { return v + get_x32(v, lane); }
__device__ __forceinline__ float max_x32(float v, int lane) { return fmaxf(v, get_x32(v, lane)); }
__device__ __forceinline__ float wave_sum(float v, int lane) {
    v += swz_xor<1>(v); v += swz_xor<2>(v); v += swz_xor<4>(v); v += swz_xor<8>(v); v += swz_xor<16>(v);
    return add_x32(v, lane);
}
__device__ __forceinline__ int tid_fresh() { int t = threadIdx.x; asm volatile("" : "+v"(t)); return t; }
__device__ __forceinline__ float max3f(float a, float b, float c) { float r; asm("v_max3_f32 %0, %1, %2, %3" : "=v"(r) : "v"(a), "v"(b), "v"(c)); return r; }
__device__ __forceinline__ float silu_f(float v) { return v / (1.0f + __expf(-v)); }

namespace pg8 {
constexpr int BM = 256, BK = 64, HALF = 128, HTB = HALF * BK * 2, STAGE_BYTES = 8 * HTB, NXCD = 8, WGM = 8;
__host__ __device__ __forceinline__ int lds_byte(int r, int c) { const int st = (r >> 4) * 2 + (c >> 5), rr = r & 15, cc = c & 31, ob = rr * 64 + cc * 2; return st * 1024 + (ob ^ (((ob >> 9) & 1) << 5)); }
__host__ __device__ __forceinline__ void stage_rc(int b, int& R, int& C) { const int st = b / 1024, sb = b % 1024, swz = sb ^ (((sb >> 9) & 1) << 5); R = (st >> 1) * 16 + swz / 64; C = (st & 1) * 32 + (swz % 64) / 2; }

struct Unit { int pm, pn; };
struct Gemm { const bf16_t* A; const bf16_t* Bt; int M, N, K, lda, ldb; };

struct StaticOrder {
    int nM, nN, nwg, G, c, lim;
    __device__ void init(int M, int N, int G_, int c_) { nM = M / BM; nN = N / BM; nwg = nM * nN; G = G_; c = c_; lim = nwg; }
    __device__ bool at(int L, Unit& u) const { return deal((long)L, u); }
    __device__ bool next(int i, Unit& u) const { const long L = (long)i * G + c; if (L >= lim) return false; return deal(L, u); }
    __device__ bool deal(long L, Unit& u) const {
        if (L >= nwg) return false;
        int wgid = (int)L; { const int q = nwg / NXCD, r = nwg % NXCD, xcd = wgid % NXCD, off = wgid / NXCD; wgid = (xcd < r ? xcd * (q + 1) : r * (q + 1) + (xcd - r) * q) + off; }
        const int nig = WGM * nN, gid = wgid / nig, fm = gid * WGM, gsz = (nM - fm) < WGM ? (nM - fm) : WGM;
        u.pm = fm + ((wgid % nig) % gsz); u.pn = (wgid % nig) / gsz; return true;
    }
};
struct OneUnit {
    int pm, pn, has;
    __device__ bool next(int i, Unit& u) const { if (i > 0 || !has) return false; u.pm = pm; u.pn = pn; return true; }
};

template <class Epi, class Sched, bool ALIGN_EPI, int NB = 2>
__device__ __forceinline__ void gemm_phase(LAS unsigned char* lds, const Gemm g, const Sched& S, const Epi& E) {
    const int tid = tid_fresh(), wid = __builtin_amdgcn_readfirstlane(tid >> 6), lane = tid & 63, wr = wid >> 2, wc = wid & 3, fr = lane & 15, fq = lane >> 4;
    const int K = g.K, nt = K / BK;
    unsigned voffA[2], voffB[2];
#pragma unroll
    for (int i = 0; i < 2; ++i) { int R, C; stage_rc(tid * 16 + i * 8192, R, C);
        voffA[i] = (unsigned)(R * g.lda + C) * 2u; voffB[i] = (unsigned)(R * g.ldb + C) * 2u; }
    const size_t kstep = (size_t)(BK * 2);
    const size_t hstepA = (size_t)HALF * g.lda * 2, hstepB = (size_t)HALF * g.ldb * 2;
    const size_t tstepA = 2 * hstepA, tstepB = 2 * hstepB;
    const unsigned ldsw = (unsigned)wid * 1024u;
    const int aoff = lds_byte(wr * 64 + fr, fq * 8), boff = lds_byte(wc * 32 + fr, fq * 8);
#define PG8_SA(b, h) (((b) * 2 + (h)) * HTB)
#define PG8_SB(b, h) ((4 + (b) * 2 + (h)) * HTB)
#define PG8_STAGE(bufoff, gbase, voff) do { _Pragma("unroll") for (int _i = 0; _i < 2; ++_i) \
        __builtin_amdgcn_global_load_lds((const unsigned*)((const char*)(gbase) + (voff)[_i]), (LAS unsigned*)(lds + (bufoff) + ldsw + _i * 8192), 16, 0, 0); } while (0)
#define PG8_LDA(dst, b, h) do { _Pragma("unroll") for (int m = 0; m < 4; ++m) _Pragma("unroll") for (int k = 0; k < 2; ++k) dst[m][k] = *(const LAS bf16x8*)(lds + PG8_SA(b, h) + aoff + m * 2048 + k * 1024); } while (0)
#define PG8_LDB(dst, b, h) do { _Pragma("unroll") for (int n = 0; n < 2; ++n) _Pragma("unroll") for (int k = 0; k < 2; ++k) dst[n][k] = *(const LAS bf16x8*)(lds + PG8_SB(b, h) + boff + n * 2048 + k * 1024); } while (0)
#define PG8_MMA(ai, bj, At, Bt) do { __builtin_amdgcn_s_setprio(1); _Pragma("unroll") for (int m = 0; m < 4; ++m) _Pragma("unroll") for (int n = 0; n < 2; ++n) _Pragma("unroll") for (int k = 0; k < 2; ++k) \
        acc[ai][bj][m][n] = __builtin_amdgcn_mfma_f32_16x16x32_bf16(Bt[n][k], At[m][k], acc[ai][bj][m][n], 0, 0, 0); __builtin_amdgcn_s_setprio(0); } while (0)
#define PG8_WAIT_V(n) asm volatile("s_waitcnt vmcnt(" #n ")" ::: "memory")
#define PG8_WAIT_L(n) asm volatile("s_waitcnt lgkmcnt(" #n ")" ::: "memory")
#define PG8_BAR __builtin_amdgcn_s_barrier()
#define PG8_SCHED __builtin_amdgcn_sched_barrier(0)
    Unit cur, nxt; int ui = 0;
    if (!S.next(0, cur)) return;
    f32x4 acc[2][2][4][2];
#pragma unroll
    for (int a = 0; a < 2; ++a)
#pragma unroll
        for (int b = 0; b < 2; ++b)
#pragma unroll
            for (int m = 0; m < 4; ++m)
#pragma unroll
                for (int n = 0; n < 2; ++n) acc[a][b][m][n] = (f32x4){0.f, 0.f, 0.f, 0.f};
    bf16x8 At[4][2], B0[2][2], B1[2][2];
    const char* cA = (const char*)g.A + (size_t)cur.pm * tstepA; const char* cB = (const char*)g.Bt + (size_t)cur.pn * tstepB;
    constexpr bool FULL = (NB == 2); constexpr int BJ = FULL ? 0 : NB;
    if constexpr (FULL) {
    PG8_STAGE(PG8_SB(0, 0), cB, voffB); PG8_STAGE(PG8_SB(0, 1), cB + hstepB, voffB); PG8_STAGE(PG8_SA(0, 0), cA, voffA); PG8_STAGE(PG8_SA(0, 1), cA + hstepA, voffA);
    if (wr == 1) PG8_BAR;
    PG8_WAIT_V(2); PG8_BAR;
    PG8_STAGE(PG8_SB(1, 0), cB + kstep, voffB); PG8_STAGE(PG8_SA(1, 0), cA + kstep, voffA); PG8_STAGE(PG8_SB(1, 1), cB + hstepB + kstep, voffB);
    PG8_WAIT_V(6); PG8_BAR;
    } else {
    PG8_STAGE(PG8_SB(0, BJ), cB + BJ * hstepB, voffB); PG8_STAGE(PG8_SA(0, 0), cA, voffA); PG8_STAGE(PG8_SA(0, 1), cA + hstepA, voffA);
    if (wr == 1) PG8_BAR;
    PG8_WAIT_V(2); PG8_BAR;
    PG8_STAGE(PG8_SB(1, BJ), cB + BJ * hstepB + kstep, voffB); PG8_STAGE(PG8_SA(1, 0), cA + kstep, voffA);
    PG8_WAIT_V(4); PG8_BAR;
    }
    for (;;) {
        const bool has_next = S.next(ui + 1, nxt);
        const char* nA = has_next ? (const char*)g.A + (size_t)nxt.pm * tstepA : cA; const char* nB = has_next ? (const char*)g.Bt + (size_t)nxt.pn * tstepB : cB;
        for (int t = 0; t < nt; t += 2) {
            const bool last = (t == nt - 2);
            const char* a1 = cA + (size_t)(t + 1) * kstep;
            const char* a2 = last ? nA : cA + (size_t)(t + 2) * kstep; const char* b2 = last ? nB : cB + (size_t)(t + 2) * kstep;
            const char* a3 = a2 + kstep; const char* b3 = b2 + kstep;
            if constexpr (FULL) {
            PG8_LDB(B0, 0, 0); PG8_LDB(B1, 0, 1); PG8_SCHED; PG8_LDA(At, 0, 0); PG8_STAGE(PG8_SA(1, 1), a1 + hstepA, voffA);
            PG8_WAIT_V(8); PG8_WAIT_L(0); PG8_BAR; PG8_MMA(0, 0, At, B0); PG8_MMA(0, 1, At, B1); PG8_BAR; PG8_SCHED;
            PG8_LDA(At, 0, 1); PG8_STAGE(PG8_SB(0, 0), b2, voffB); PG8_STAGE(PG8_SB(0, 1), b2 + hstepB, voffB); PG8_STAGE(PG8_SA(0, 0), a2, voffA);
            PG8_WAIT_V(8); PG8_WAIT_L(0); PG8_BAR; PG8_MMA(1, 0, At, B0); PG8_MMA(1, 1, At, B1); PG8_BAR; PG8_SCHED;
            PG8_LDB(B0, 1, 0); PG8_LDB(B1, 1, 1); PG8_SCHED; PG8_LDA(At, 1, 0); PG8_STAGE(PG8_SA(0, 1), a2 + hstepA, voffA);
            PG8_WAIT_V(8); PG8_WAIT_L(0); PG8_BAR; PG8_MMA(0, 0, At, B0); PG8_MMA(0, 1, At, B1); PG8_BAR; PG8_SCHED;
            PG8_LDA(At, 1, 1); PG8_STAGE(PG8_SB(1, 0), b3, voffB); PG8_STAGE(PG8_SB(1, 1), b3 + hstepB, voffB); PG8_STAGE(PG8_SA(1, 0), a3, voffA);
            PG8_WAIT_V(8); PG8_WAIT_L(0); PG8_BAR; PG8_MMA(1, 0, At, B0); PG8_MMA(1, 1, At, B1); PG8_BAR; PG8_SCHED;
            } else {
            PG8_LDB(B0, 0, BJ); PG8_SCHED; PG8_LDA(At, 0, 0); PG8_STAGE(PG8_SA(1, 1), a1 + hstepA, voffA);
            PG8_WAIT_V(6); PG8_WAIT_L(0); PG8_BAR; PG8_MMA(0, BJ, At, B0); PG8_BAR; PG8_SCHED;
            PG8_LDA(At, 0, 1); PG8_STAGE(PG8_SB(0, BJ), b2 + BJ * hstepB, voffB); PG8_STAGE(PG8_SA(0, 0), a2, voffA);
            PG8_WAIT_V(6); PG8_WAIT_L(0); PG8_BAR; PG8_MMA(1, BJ, At, B0); PG8_BAR; PG8_SCHED;
            PG8_LDB(B0, 1, BJ); PG8_SCHED; PG8_LDA(At, 1, 0); PG8_STAGE(PG8_SA(0, 1), a2 + hstepA, voffA);
            PG8_WAIT_V(6); PG8_WAIT_L(0); PG8_BAR; PG8_MMA(0, BJ, At, B0); PG8_BAR; PG8_SCHED;
            PG8_LDA(At, 1, 1); PG8_STAGE(PG8_SB(1, BJ), b3 + BJ * hstepB, voffB); PG8_STAGE(PG8_SA(1, 0), a3, voffA);
            PG8_WAIT_V(6); PG8_WAIT_L(0); PG8_BAR; PG8_MMA(1, BJ, At, B0); PG8_BAR; PG8_SCHED;
            }
        }
        if constexpr (ALIGN_EPI) { if (wr == 0) PG8_BAR; }
        if constexpr (!Epi::AFTER_DRAIN) E(acc, cur, wr, wc, fr, fq);
        if (!has_next) break;
#pragma unroll
        for (int a = 0; a < 2; ++a)
#pragma unroll
            for (int b = 0; b < 2; ++b)
#pragma unroll
                for (int m = 0; m < 4; ++m)
#pragma unroll
                    for (int n = 0; n < 2; ++n) acc[a][b][m][n] = (f32x4){0.f, 0.f, 0.f, 0.f};
        cur = nxt; cA = nA; cB = nB; ++ui;
        if constexpr (ALIGN_EPI) { if (wr == 1) PG8_BAR; }
    }
    PG8_WAIT_V(0);
    if constexpr (!ALIGN_EPI) { if (wr == 0) PG8_BAR; }
    PG8_BAR;
    if constexpr (Epi::AFTER_DRAIN) E.fused(acc, cur, wr, wc, fr, fq, lds, wid, lane);
#undef PG8_SA
#undef PG8_SB
#undef PG8_STAGE
#undef PG8_LDA
#undef PG8_LDB
#undef PG8_MMA
#undef PG8_WAIT_V
#undef PG8_WAIT_L
#undef PG8_BAR
#undef PG8_SCHED
}

struct EpiF32 {
    static constexpr bool AFTER_DRAIN = false;
    bf16_t* Z; int ldc; bf16_t* V; bf16_t* Q; bf16_t* K; float* kmean; const float* gq; const float* gk; const float* cosT; const float* sinT; LAS float* xl;
    __device__ __forceinline__ void operator()(const f32x4 (&acc)[2][2][4][2], const Unit& uu, int wr, int wc, int fr_in, int fq_in) const {
        int fr = fr_in, fq = fq_in; asm volatile("" : "+v"(fr), "+v"(fq));
        Unit u = uu; u.pn = (uu.pn >= 4 && uu.pn < 12) ? (uu.pn < 8 ? uu.pn + 4 : uu.pn - 4) : uu.pn;
        const int row0 = u.pm * BM + wr * 64 + fr, col0 = u.pn * BM + wc * 32 + 4 * fq;
        const int b = u.pm >> 3, sblk = u.pm & 7;
        if (u.pn < 8) {
            const bool isK = u.pn >= 4;
            LAS float* P = xl;
            LAS float* KMS = xl + 2048;
#pragma unroll
            for (int ai = 0; ai < 2; ++ai)
#pragma unroll
                for (int m = 0; m < 4; ++m)
#pragma unroll
                    for (int bj = 0; bj < 2; ++bj) { const f32x4 x0 = acc[ai][bj][m][0], x1 = acc[ai][bj][m][1];
                        float ssq = (x0[0] * x0[0] + x0[1] * x0[1]) + (x0[2] * x0[2] + x0[3] * x0[3]) + (x1[0] * x1[0] + x1[1] * x1[1]) + (x1[2] * x1[2] + x1[3] * x1[3]);
                        ssq += swz_xor<16>(ssq); ssq = add_x32(ssq, (fq * 16 + fr));
                        if (fq == 0) P[((ai * HALF + wr * 64 + m * 16 + fr) * 2 + bj) * 4 + wc] = ssq; }
            asm volatile("s_waitcnt lgkmcnt(0)" ::: "memory"); __builtin_amdgcn_s_barrier(); asm volatile("" ::: "memory");
            const float* gg = isK ? gk : gq;
            const int dl = 16 * wc + 4 * fq;
            const f32x4 g0 = *(const f32x4*)(gg + dl), g1 = *(const f32x4*)(gg + 64 + dl);
            f32x4 km0[2], km1[2];
#pragma unroll
            for (int bj = 0; bj < 2; ++bj) { km0[bj] = (f32x4){0.f, 0.f, 0.f, 0.f}; km1[bj] = (f32x4){0.f, 0.f, 0.f, 0.f}; }
            bf16_t* dbase = (isK ? K : Q) + ((size_t)(b * 8 + (u.pn & 3) * 2) * 2048 + sblk * 256) * 128 + dl;
#pragma unroll
            for (int ai = 0; ai < 2; ++ai)
#pragma unroll
                for (int m = 0; m < 4; ++m) { const int rl = ai * HALF + wr * 64 + m * 16 + fr; const size_t grow = (size_t)u.pm * BM + rl;
                    const f32x4 cs = *(const f32x4*)(cosT + grow * 64 + dl), sn = *(const f32x4*)(sinT + grow * 64 + dl);
#pragma unroll
                    for (int bj = 0; bj < 2; ++bj) { const f32x4 pp = *(const LAS f32x4*)(P + (rl * 2 + bj) * 4);
                        const float rstd = 1.0f / sqrtf(((pp[0] + pp[1]) + (pp[2] + pp[3])) * (1.0f / 128.0f) + 1e-6f);
                        const f32x4 n0 = acc[ai][bj][m][0] * rstd * g0, n1 = acc[ai][bj][m][1] * rstd * g1;
                        const f32x4 o0 = n0 * cs - n1 * sn, o1 = n1 * cs + n0 * sn;
                        bf16_t* dp = dbase + ((size_t)bj * 2048 + rl) * 128;
                        u32x2 w0, w1; w0.x = pk2(o0[0], o0[1]); w0.y = pk2(o0[2], o0[3]); w1.x = pk2(o1[0], o1[1]); w1.y = pk2(o1[2], o1[3]);
                        *(u32x2*)dp = w0; *(u32x2*)(dp + 64) = w1;
                        km0[bj] += o0; km1[bj] += o1; }
                    asm volatile("" ::: "memory"); }
            if (isK) {
#pragma unroll
                for (int bj = 0; bj < 2; ++bj)
#pragma unroll
                    for (int j = 0; j < 4; ++j) { float a0 = km0[bj][j], a1 = km1[bj][j];
                        a0 += swz_xor<1>(a0); a0 += swz_xor<2>(a0); a0 += swz_xor<4>(a0); a0 += swz_xor<8>(a0);
                        a1 += swz_xor<1>(a1); a1 += swz_xor<2>(a1); a1 += swz_xor<4>(a1); a1 += swz_xor<8>(a1);
                        if (fr == 0) { KMS[(wr * 2 + bj) * 128 + dl + j] = a0; KMS[(wr * 2 + bj) * 128 + 64 + dl + j] = a1; } }
                asm volatile("s_waitcnt lgkmcnt(0)" ::: "memory"); __builtin_amdgcn_s_barrier(); asm volatile("" ::: "memory");
                const int t = (wr * 4 + wc) * 64 + fq * 16 + fr;
                if (t < 256) { const int bj = t >> 7, d = t & 127;
                    kmean[((size_t)(b * 8 + (u.pn & 3) * 2 + bj) * 8 + sblk) * 128 + d] = (KMS[bj * 128 + d] + KMS[(2 + bj) * 128 + d]) * (1.0f / 256.0f); }
            }
            return;
        }
        if (u.pn < 12) {
            const int s0 = sblk * BM + wr * 64 + fr;
#pragma unroll
            for (int bj = 0; bj < 2; ++bj) { bf16_t* hp = V + ((size_t)(b * 8 + (u.pn - 8) * 2 + bj) * 2048 + s0) * 128 + wc * 32 + 4 * fq;
#pragma unroll
                for (int ai = 0; ai < 2; ++ai)
#pragma unroll
                    for (int m = 0; m < 4; ++m)
#pragma unroll
                        for (int n = 0; n < 2; ++n) { const f32x4 v = acc[ai][bj][m][n]; u32x2 w; w.x = pk2(v[0], v[1]); w.y = pk2(v[2], v[3]); *(u32x2*)(hp + (size_t)(ai * HALF + m * 16) * 128 + n * 16) = w; } }
            return;
        }
#pragma unroll
        for (int ai = 0; ai < 2; ++ai)
#pragma unroll
            for (int m = 0; m < 4; ++m) { bf16_t* rowp = Z + (size_t)(row0 + ai * HALF + m * 16) * ldc + col0;
#pragma unroll
                for (int bj = 0; bj < 2; ++bj)
#pragma unroll
                    for (int n = 0; n < 2; ++n) { const f32x4 v = acc[ai][bj][m][n]; u32x2 w; w.x = pk2(v[0], v[1]); w.y = pk2(v[2], v[3]); *(u32x2*)(rowp + bj * HALF + n * 16) = w; } }
    }
};
struct EpiScaleBf16 {
    static constexpr bool AFTER_DRAIN = false;
    bf16_t* O; int ldc; const float* scale;
    __device__ __forceinline__ void operator()(const f32x4 (&acc)[2][2][4][2], const Unit& u, int wr, int wc, int fr, int fq) const {
        const int row0 = u.pm * BM + wr * 64 + fr, col0 = u.pn * BM + wc * 32 + 4 * fq;
        f32x4 sv[2][2];
#pragma unroll
        for (int bj = 0; bj < 2; ++bj)
#pragma unroll
            for (int n = 0; n < 2; ++n) sv[bj][n] = *(const f32x4*)(scale + col0 + bj * HALF + n * 16);
#pragma unroll
        for (int ai = 0; ai < 2; ++ai)
#pragma unroll
            for (int m = 0; m < 4; ++m) { bf16_t* rowp = O + (size_t)(row0 + ai * HALF + m * 16) * ldc + col0;
#pragma unroll
                for (int bj = 0; bj < 2; ++bj)
#pragma unroll
                    for (int n = 0; n < 2; ++n) { const f32x4 v = acc[ai][bj][m][n] * sv[bj][n]; u32x2 w; w.x = pk2(v[0], v[1]); w.y = pk2(v[2], v[3]); *(u32x2*)(rowp + bj * HALF + n * 16) = w; } }
    }
};
struct EpiGateRes {
    static constexpr bool AFTER_DRAIN = false;
    const float* base; float* out; int ldc; const float* gate; int ldg;
    __device__ __forceinline__ void operator()(const f32x4 (&acc)[2][2][4][2], const Unit& u, int wr, int wc, int fr, int fq) const {
        const int row0 = u.pm * BM + wr * 64 + fr, col0 = u.pn * BM + wc * 32 + 4 * fq;
        const float* gp = gate + (size_t)(u.pm >> 3) * ldg + col0;
        f32x4 gv[2][2];
#pragma unroll
        for (int bj = 0; bj < 2; ++bj)
#pragma unroll
            for (int n = 0; n < 2; ++n) gv[bj][n] = *(const f32x4*)(gp + bj * HALF + n * 16);
#pragma unroll
        for (int ai = 0; ai < 2; ++ai) {
            f32x4 bs[4][2][2];
#pragma unroll
            for (int m = 0; m < 4; ++m)
#pragma unroll
                for (int bj = 0; bj < 2; ++bj)
#pragma unroll
                    for (int n = 0; n < 2; ++n) bs[m][bj][n] = __builtin_nontemporal_load((const f32x4*)(base + (size_t)(row0 + ai * HALF + m * 16) * ldc + col0 + bj * HALF + n * 16));
#pragma unroll
            for (int m = 0; m < 4; ++m) { const size_t off = (size_t)(row0 + ai * HALF + m * 16) * ldc + col0;
#pragma unroll
                for (int bj = 0; bj < 2; ++bj)
#pragma unroll
                    for (int n = 0; n < 2; ++n) __builtin_nontemporal_store(bs[m][bj][n] + gv[bj][n] * acc[ai][bj][m][n], (f32x4*)(out + off + bj * HALF + n * 16)); }
            asm volatile("" ::: "memory"); }
    }
};
struct EpiGateResNorm {
    static constexpr bool AFTER_DRAIN = true;
    const float* base; float* out; int ldc; const float* gate; const float* gnorm; const float* sc; const float* sh; int ldg;
    bf16_t* xn; float* slots; unsigned* cnt;
    __device__ __forceinline__ void fused(f32x4 (&acc)[2][2][4][2], const Unit& u, int wr, int wc, int fr, int fq, LAS unsigned char* lds, int wid, int lane) const {
        LAS float* P = (LAS float*)lds;
        LAS float* S = (LAS float*)(lds + 4096);
        const int row0 = u.pm * BM + wr * 64 + fr, col0 = u.pn * BM + wc * 32 + 4 * fq, b = u.pm >> 3;
        {
            f32x4 gv[2][2];
#pragma unroll
            for (int bj = 0; bj < 2; ++bj)
#pragma unroll
                for (int n = 0; n < 2; ++n) gv[bj][n] = *(const f32x4*)(gate + (size_t)b * ldg + col0 + bj * HALF + n * 16);
#pragma unroll
            for (int ai = 0; ai < 2; ++ai) {
                f32x4 bs[4][2][2];
#pragma unroll
                for (int m = 0; m < 4; ++m)
#pragma unroll
                    for (int bj = 0; bj < 2; ++bj)
#pragma unroll
                        for (int n = 0; n < 2; ++n) bs[m][bj][n] = __builtin_nontemporal_load((const f32x4*)(base + (size_t)(row0 + ai * HALF + m * 16) * ldc + col0 + bj * HALF + n * 16));
#pragma unroll
                for (int m = 0; m < 4; ++m) { const size_t off = (size_t)(row0 + ai * HALF + m * 16) * ldc + col0; float ssq = 0.f;
#pragma unroll
                    for (int bj = 0; bj < 2; ++bj)
#pragma unroll
                        for (int n = 0; n < 2; ++n) { const f32x4 v = bs[m][bj][n] + gv[bj][n] * acc[ai][bj][m][n];
                            acc[ai][bj][m][n] = v; ssq += (v[0] * v[0] + v[1] * v[1]) + (v[2] * v[2] + v[3] * v[3]); }
                    ssq += swz_xor<16>(ssq); ssq = add_x32(ssq, (fq * 16 + fr));
                    if (fq == 0) P[(ai * HALF + wr * 64 + m * 16 + fr) * 4 + wc] = ssq; }
                asm volatile("" ::: "memory"); }
        }
        asm volatile("s_waitcnt lgkmcnt(0)" ::: "memory"); __builtin_amdgcn_s_barrier(); asm volatile("" ::: "memory");
        const int tid = wid * 64 + lane;
        if (tid < 256) { const f32x4 p = *(const LAS f32x4*)(P + tid * 4);
            __hip_atomic_store(slots + ((size_t)u.pm * 256 + tid) * 8 + u.pn, (p[0] + p[1]) + (p[2] + p[3]), __ATOMIC_RELAXED, __HIP_MEMORY_SCOPE_AGENT); }
        asm volatile("s_waitcnt vmcnt(0)" ::: "memory");
        if (tid < 256 && lane == 0) __hip_atomic_fetch_add(cnt + 64 * u.pm, 1u, __ATOMIC_RELAXED, __HIP_MEMORY_SCOPE_AGENT);
#define X1_STORES() do { _Pragma("unroll") for (int ai = 0; ai < 2; ++ai) _Pragma("unroll") for (int m = 0; m < 4; ++m) { const size_t off = (size_t)(row0 + ai * HALF + m * 16) * ldc + col0; \
            _Pragma("unroll") for (int bj = 0; bj < 2; ++bj) _Pragma("unroll") for (int n = 0; n < 2; ++n) __builtin_nontemporal_store(acc[ai][bj][m][n], (f32x4*)(out + off + bj * HALF + n * 16)); } } while (0)
        if (wid != 0) X1_STORES();
        if (wid == 0) {
            unsigned sp = 0;
            while ((unsigned)__builtin_amdgcn_readfirstlane((int)__hip_atomic_load(cnt + 64 * u.pm, __ATOMIC_RELAXED, __HIP_MEMORY_SCOPE_AGENT)) < 32u) { __builtin_amdgcn_s_sleep(2); if (++sp > (1u << 22)) break; }
            __builtin_amdgcn_fence(__ATOMIC_ACQUIRE, "agent");
            asm volatile("s_waitcnt vmcnt(0)" ::: "memory");
            X1_STORES();
        }
#undef X1_STORES
        asm volatile("s_waitcnt lgkmcnt(0)" ::: "memory"); __builtin_amdgcn_s_barrier(); asm volatile("" ::: "memory");
        if (tid < 256) { const float* sl = slots + ((size_t)u.pm * 256 + tid) * 8; float t = 0.f;
#pragma unroll
            for (int k = 0; k < 8; ++k) t += __hip_atomic_load(sl + k, __ATOMIC_RELAXED, __HIP_MEMORY_SCOPE_AGENT);
            S[tid] = 1.0f / sqrtf(t * (1.0f / 2048.0f) + 1e-6f); }
        asm volatile("s_waitcnt lgkmcnt(0)" ::: "memory"); __builtin_amdgcn_s_barrier(); asm volatile("" ::: "memory");
        f32x4 av[2][2], sv[2][2];
#pragma unroll
        for (int bj = 0; bj < 2; ++bj)
#pragma unroll
            for (int n = 0; n < 2; ++n) { const int c = col0 + bj * HALF + n * 16; const f32x4 g4 = *(const f32x4*)(gnorm + c), s4 = *(const f32x4*)(sc + (size_t)b * ldg + c);
                av[bj][n] = g4 * (s4 + 1.0f); sv[bj][n] = *(const f32x4*)(sh + (size_t)b * ldg + c); }
#pragma unroll
        for (int ai = 0; ai < 2; ++ai)
#pragma unroll
            for (int m = 0; m < 4; ++m) { const int rl = ai * HALF + wr * 64 + m * 16 + fr; const float rstd = S[rl]; bf16_t* rowp = xn + (size_t)(u.pm * BM + rl) * ldc + col0;
#pragma unroll
                for (int bj = 0; bj < 2; ++bj)
#pragma unroll
                    for (int n = 0; n < 2; ++n) { const f32x4 o = acc[ai][bj][m][n] * rstd * av[bj][n] + sv[bj][n]; u32x2 w; w.x = pk2(o[0], o[1]); w.y = pk2(o[2], o[3]); *(u32x2*)(rowp + bj * HALF + n * 16) = w; } }
    }
};
struct EpiSwiGLU {
    static constexpr bool AFTER_DRAIN = false;
    bf16_t* H; int ldc; int bjsel;
    __device__ __forceinline__ void operator()(const f32x4 (&acc)[2][2][4][2], const Unit& u, int wr, int wc, int fr, int fq) const {
        const int row0 = u.pm * BM + wr * 64 + fr;
#pragma unroll
        for (int ai = 0; ai < 2; ++ai)
#pragma unroll
            for (int m = 0; m < 4; ++m) { bf16_t* rowp = H + (size_t)(row0 + ai * HALF + m * 16) * ldc;
#pragma unroll
                for (int bj = 0; bj < 2; ++bj) { if (bjsel >= 0 && bj != bjsel) continue; const int G = u.pn * 8 + bj * 4 + wc; const f32x4 gt = acc[ai][bj][m][0], up = acc[ai][bj][m][1]; f32x4 o;
#pragma unroll
                    for (int j = 0; j < 4; ++j) { const float e = __builtin_amdgcn_exp2f(gt[j] * -1.4426950408889634f); o[j] = gt[j] * __builtin_amdgcn_rcpf(1.0f + e) * up[j]; }
                    u32x2 w; w.x = pk2(o[0], o[1]); w.y = pk2(o[2], o[3]); *(u32x2*)(rowp + 16 * G + 4 * fq) = w; } }
    }
};
}

struct Args {
    const float* x; const float* c; const int* pos; const float* w_ada; const float* b_ada; const float* g_mix; const float* w_in; const float* g_q; const float* g_k;
    const float* w_pool; const float* pool_scale; const float* w_out; const float* g_ffn; const float* w_gate; const float* w_up; const float* w_down;
    float* out; unsigned char* ws;
};

__device__ __forceinline__ void p0_ada(const Args& a, LAS float* ldsf) {
    const int tid = tid_fresh();
    for (int i = tid; i < NB * DM; i += NTHR) ldsf[i] = silu_f(a.c[i]);
    __syncthreads();
    float* part = (float*)(a.ws + WS_PART);
    LAS float* red = ldsf + NB * DM;
    const int l16 = tid & 15, rg = tid >> 4;
    for (int it = blockIdx.x; it < 768; it += gridDim.x) {
        const int cgp = it % 192, kq = it / 192;
        const int e0 = cgp * 64 + 4 * l16, d0 = kq * 512 + rg * 16;
        f32x4 acc[4];
#pragma unroll
        for (int b = 0; b < 4; ++b) acc[b] = (f32x4){0.f, 0.f, 0.f, 0.f};
        f32x4 w[16];
#pragma unroll
        for (int i = 0; i < 16; ++i) w[i] = __builtin_nontemporal_load((const f32x4*)(a.w_ada + (size_t)(d0 + i) * MODW + e0));
#pragma unroll
        for (int i = 0; i < 16; ++i)
#pragma unroll
            for (int b = 0; b < 4; ++b) acc[b] += w[i] * ldsf[b * DM + d0 + i];
#pragma unroll
        for (int b = 0; b < 4; ++b) *(LAS f32x4*)(red + (rg * 4 + b) * 64 + 4 * l16) = acc[b];
        __syncthreads();
        if (tid < 256) { const int b = tid >> 6, col = tid & 63; float s = 0.f;
#pragma unroll 8
            for (int r = 0; r < 32; ++r) s += red[(r * 4 + b) * 64 + col];
            part[(size_t)(kq * 4 + b) * MODW + cgp * 64 + col] = s; }
        __syncthreads();
    }
}
__device__ __forceinline__ void conv_item(const float* W, int N, bf16_t* WT, int ldt, int mode, LAS float* scr, int item, int lane) {
    const int nblk = N / 64, kb = item / nblk, nb = item % nblk, k0 = 64 * kb, n0 = 64 * nb;
    const int l32 = lane & 31, lh = lane >> 5;
    f32x2 v[32];
#pragma unroll
    for (int i = 0; i < 32; ++i) v[i] = __builtin_nontemporal_load((const f32x2*)(W + (size_t)(k0 + 2 * i + lh) * N + n0 + 2 * l32));
#pragma unroll
    for (int i = 0; i < 32; ++i) { const int kk = 2 * i + lh; scr[kk * 65 + 2 * l32] = v[i].x; scr[kk * 65 + 2 * l32 + 1] = v[i].y; }
    asm volatile("s_waitcnt lgkmcnt(0)" ::: "memory");
    const int c = lane & 7;
#pragma unroll
    for (int j = 0; j < 8; ++j) { const int n = (lane >> 3) + 8 * j; const LAS float* s = scr + (8 * c) * 65 + n;
        u32x4 o; o.x = pk2(s[0 * 65], s[1 * 65]); o.y = pk2(s[2 * 65], s[3 * 65]); o.z = pk2(s[4 * 65], s[5 * 65]); o.w = pk2(s[6 * 65], s[7 * 65]);
        const int gn = n0 + n; int row;
        if (mode == 0) row = gn;
        else if (mode == 3) { row = gn < 2 * AW ? ((gn & ~127) + 32 * ((gn & 63) >> 4) + 16 * ((gn >> 6) & 1) + (gn & 15)) : gn;
                              if (gn >= AW && gn < 3 * AW) row += (gn < 2 * AW) ? AW : -AW; }
        else row = 32 * (gn >> 4) + (gn & 15) + (mode == 2 ? 16 : 0);
        *(u32x4*)(WT + (size_t)row * ldt + k0 + 8 * c) = o; }
    asm volatile("s_waitcnt lgkmcnt(0)" ::: "memory");
}
template <int PART>
__device__ __forceinline__ void p0_convert(const Args& a, LAS unsigned char* lds, int wg, int nwg, const float* wdown, const float* wup = nullptr) {
    const int tid = tid_fresh(), lane = tid & 63, wave = __builtin_amdgcn_readfirstlane(tid >> 6);
    LAS float* scr = (LAS float*)(lds + wave * 16640);
    const int gw = wg * NWAVES + wave, NGW = nwg * NWAVES;
    constexpr int I_IN = (DM / 64) * (INW / 64), I_OUT = (DM / 64) * (DM / 64), I_G = (DM / 64) * (DFF / 64), I_D = (DFF / 64) * (DM / 64), I_P = 16;
    if (PART == 1) { for (int it = gw; it < I_D; it += NGW) conv_item(wdown, DM, (bf16_t*)(a.ws + WS_WDN), DFF, 0, scr, it, lane); return; }
    if (PART == 2) { bf16_t* wgu = (bf16_t*)(a.ws + WS_WGU);
        for (int it = gw; it < 2 * I_G; it += NGW) { if (it < I_G) conv_item(wdown, DFF, wgu, DM, 1, scr, it, lane); else conv_item(wup, DFF, wgu, DM, 2, scr, it - I_G, lane); } return; }
    constexpr int NIT = I_IN + I_OUT + 4 * I_P;
    for (int it = gw; it < NIT; it += NGW) {
        int r = it;
        if (r < I_IN) { conv_item(a.w_in, INW, (bf16_t*)(a.ws + WS_WIN), DM, 3, scr, r, lane); continue; } r -= I_IN;
        if (r < I_OUT) { conv_item(a.w_out, DM, (bf16_t*)(a.ws + WS_WOUT), DM, 0, scr, r, lane); continue; } r -= I_OUT;
        const int g = r / I_P; r -= g * I_P;
        conv_item(a.w_pool + (size_t)g * 65536, 256, (bf16_t*)(a.ws + WS_WPOOL) + (size_t)g * 65536, 256, 0, scr, r, lane);
    }
}

template <bool FROM_PART>
__device__ __forceinline__ void norm_phase(const Args& a, const float* X, const float* g, int sh_idx, int sc_idx, bf16_t* OUT, LAS float* ldsf) {
    const int tid = tid_fresh(), lane = tid & 63, wave = tid >> 6;
    const float* part = (const float*)(a.ws + WS_PART);
    float* mod = (float*)(a.ws + WS_MOD);
    if (FROM_PART) {
        for (int i = blockIdx.x * NTHR + tid; i < NB * MODW; i += gridDim.x * NTHR) { const int b = i / MODW, e = i % MODW;
            float s = a.b_ada[e];
#pragma unroll
            for (int kq = 0; kq < 4; ++kq) s += part[(size_t)(kq * 4 + b) * MODW + e];
            mod[i] = s; }
    }
    LAS float* sa = ldsf; LAS float* ss = ldsf + DM;
    int cur_b = -1;
    const float invf = (float)exp2(-(double)(tid & 63) * (13.287712379549449 / 64.0));
    for (int rb = blockIdx.x; rb < MTOK / 32; rb += gridDim.x) {
        const int b = rb / (SEQ / 32);
        if (FROM_PART) {
            float* ct = (float*)(a.ws + WS_COS) + (size_t)rb * 32 * 64; float* st = (float*)(a.ws + WS_SIN) + (size_t)rb * 32 * 64;
#pragma unroll
            for (int k = 0; k < 4; ++k) { const int idx = tid + NTHR * k; const float ang = (float)a.pos[rb * 32 + (idx >> 6)] * invf; float sn, cs; sincosf(ang, &sn, &cs); ct[idx] = cs; st[idx] = sn; }
        }
        if (b != cur_b) {
            __syncthreads();
            for (int d = tid; d < DM; d += NTHR) {
                float sc, sh;
                if (FROM_PART) { sc = a.b_ada[sc_idx * DM + d]; sh = a.b_ada[sh_idx * DM + d];
#pragma unroll
                    for (int kq = 0; kq < 4; ++kq) { sc += part[(size_t)(kq * 4 + b) * MODW + sc_idx * DM + d]; sh += part[(size_t)(kq * 4 + b) * MODW + sh_idx * DM + d]; } }
                else { sc = mod[(size_t)b * MODW + sc_idx * DM + d]; sh = mod[(size_t)b * MODW + sh_idx * DM + d]; }
                sa[d] = g[d] * (1.0f + sc); ss[d] = sh; }
            __syncthreads();
            cur_b = b;
        }
#pragma unroll 1
        for (int i = 0; i < 4; ++i) {
            const int row = rb * 32 + wave * 4 + i;
            const f32x4* xr = (const f32x4*)(X + (size_t)row * DM) + lane;
            f32x4 v[8]; float s = 0.f;
#pragma unroll
            for (int j = 0; j < 8; ++j) { v[j] = __builtin_nontemporal_load(xr + 64 * j); s += (v[j].x * v[j].x + v[j].y * v[j].y) + (v[j].z * v[j].z + v[j].w * v[j].w); }
            const float rstd = 1.0f / sqrtf(wave_sum(s, lane) * (1.0f / DM) + EPS);
            u32x2* op = (u32x2*)(OUT + (size_t)row * DM) + lane;
#pragma unroll
            for (int j = 0; j < 8; ++j) { const int d = 4 * (lane + 64 * j); const f32x4 av = *(const LAS f32x4*)(sa + d), sv = *(const LAS f32x4*)(ss + d);
                const f32x4 o = v[j] * rstd * av + sv; u32x2 w; w.x = pk2(o[0], o[1]); w.y = pk2(o[2], o[3]); op[64 * j] = w; }
        }
    }
    __syncthreads();
}

__device__ __forceinline__ f32x4 ld_bf4(const bf16_t* p) { const u32x2 w = __builtin_nontemporal_load((const u32x2*)p); return (f32x4){__builtin_bit_cast(float, w.x << 16), __builtin_bit_cast(float, w.x & 0xffff0000u), __builtin_bit_cast(float, w.y << 16), __builtin_bit_cast(float, w.y & 0xffff0000u)}; }
template <int W>
__device__ __forceinline__ void p3_pool(const bf16_t* zc, bf16_t* pb, int s0) {
    f32x4 prev[W - 1], u[16];
#pragma unroll
    for (int j = 0; j < W - 1; ++j) { const int k = (W - 1) - j; prev[j] = (s0 - k >= 0) ? ld_bf4(zc - (long)k * INW) : (f32x4){0.f, 0.f, 0.f, 0.f}; }
#pragma unroll
    for (int i = 0; i < 16; ++i) u[i] = ld_bf4(zc + (size_t)i * INW);
    f32x4 acc = (f32x4){0.f, 0.f, 0.f, 0.f};
#pragma unroll
    for (int j = 0; j < W - 1; ++j) acc += prev[j];
#pragma unroll
    for (int i = 0; i < 16; ++i) {
        const int t = s0 + i;
        acc += u[i];
        const float inv = 1.0f / (float)(t + 1 < W ? t + 1 : W);
        const f32x4 o = acc * inv - u[i];
        u32x2 w; w.x = pk2(o[0], o[1]); w.y = pk2(o[2], o[3]); *(u32x2*)(pb + (size_t)i * PW) = w;
        acc -= (i - W + 1 >= 0) ? u[(i - W + 1 >= 0) ? i - W + 1 : 0] : prev[(i < W - 1) ? i : 0];
    }
}
__device__ __forceinline__ void p3_unit(const Args& a, int rb, int cgi, LAS float* ldsf) {
    const int tid = tid_fresh(), lane = tid & 63, wave = tid >> 6;
    const bf16_t* Z = (const bf16_t*)(a.ws + WS_ZF);
    const int b = rb >> 3, sblk = rb & 7;
    const int row0 = rb * 256 + wave * 32, s0 = sblk * 256 + wave * 32;
    if (cgi < 16) {
        const int head = cgi & 7; const bool isK = cgi >= 8;
        const float* gg = isK ? a.g_k : a.g_q;
        const int sub = lane >> 4, d0 = 4 * (lane & 15);
        const f32x4 g0 = *(const f32x4*)(gg + d0), g1 = *(const f32x4*)(gg + 64 + d0);
        bf16_t* dst = (bf16_t*)(a.ws + (isK ? WS_K : WS_Q)) + ((size_t)(b * NH + head) * SEQ + s0 + sub) * HD + d0;
        const bf16_t* zp = Z + (size_t)(row0 + sub) * INW + cgi * 128 + d0;
        const float* ct = (const float*)(a.ws + WS_COS) + (size_t)(row0 + sub) * 64 + d0;
        const float* st = (const float*)(a.ws + WS_SIN) + (size_t)(row0 + sub) * 64 + d0;
        f32x4 km0 = (f32x4){0.f, 0.f, 0.f, 0.f}, km1 = (f32x4){0.f, 0.f, 0.f, 0.f};
#pragma unroll 4
        for (int p = 0; p < 8; ++p) {
            const f32x4 x0 = ld_bf4(zp + (size_t)(4 * p) * INW), x1 = ld_bf4(zp + (size_t)(4 * p) * INW + 64);
            const f32x4 cs = *(const f32x4*)(ct + (size_t)(4 * p) * 64), sn = *(const f32x4*)(st + (size_t)(4 * p) * 64);
            float ssq = (x0[0] * x0[0] + x0[1] * x0[1]) + (x0[2] * x0[2] + x0[3] * x0[3]) + (x1[0] * x1[0] + x1[1] * x1[1]) + (x1[2] * x1[2] + x1[3] * x1[3]);
            ssq += swz_xor<1>(ssq); ssq += swz_xor<2>(ssq); ssq += swz_xor<4>(ssq); ssq += swz_xor<8>(ssq);
            const float rstd = 1.0f / sqrtf(ssq * (1.0f / HD) + EPS);
            const f32x4 n0 = x0 * rstd * g0, n1 = x1 * rstd * g1;
            const f32x4 o0 = n0 * cs - n1 * sn, o1 = n1 * cs + n0 * sn;
            u32x2 w0, w1; w0.x = pk2(o0[0], o0[1]); w0.y = pk2(o0[2], o0[3]); w1.x = pk2(o1[0], o1[1]); w1.y = pk2(o1[2], o1[3]);
            *(u32x2*)(dst + (size_t)(4 * p) * HD) = w0; *(u32x2*)(dst + (size_t)(4 * p) * HD + 64) = w1;
            km0 += o0; km1 += o1;
        }
        if (isK) {
#pragma unroll
            for (int j = 0; j < 4; ++j) { km0[j] += swz_xor<16>(km0[j]); km0[j] = add_x32(km0[j], lane); km1[j] += swz_xor<16>(km1[j]); km1[j] = add_x32(km1[j], lane); }
            if (sub == 0) { *(LAS f32x4*)(ldsf + wave * 128 + d0) = km0; *(LAS f32x4*)(ldsf + wave * 128 + 64 + d0) = km1; }
            __syncthreads();
            if (tid < 128) { float s = 0.f;
#pragma unroll
                for (int w = 0; w < 8; ++w) s += ldsf[w * 128 + tid];
                ((float*)(a.ws + WS_KMEAN))[((size_t)(b * NH + head) * NBLK + sblk) * HD + tid] = s * (1.0f / MBLK); }
            __syncthreads();
        }
    } else {
        const int uc0 = (cgi - 24) * 128, grp = (cgi - 24) >> 1;
        const int hrow = 16 * (lane >> 5), c4 = 4 * (lane & 31);
        const bf16_t* zc = Z + (size_t)(row0 + hrow) * INW + 3 * AW + uc0 + c4;
        bf16_t* pb = (bf16_t*)(a.ws + WS_PB) + (size_t)(row0 + hrow) * PW + uc0 + c4;
        if (grp == 0) p3_pool<2>(zc, pb, s0 + hrow); else if (grp == 1) p3_pool<4>(zc, pb, s0 + hrow); else if (grp == 2) p3_pool<8>(zc, pb, s0 + hrow); else p3_pool<16>(zc, pb, s0 + hrow);
    }
}

constexpr int AT_NS = 4, AT_SLOT = 32768, AT_KM = AT_NS * AT_SLOT;
typedef short v4i16_t __attribute__((ext_vector_type(4)));
__device__ __forceinline__ void glds16(const void* gsrc, unsigned lds_dst) { unsigned keep;
    asm volatile("s_mov_b32 %0, m0\n\ts_mov_b32 m0, %2\n\ts_nop 0\n\tglobal_load_lds_dwordx4 %1, off\n\ts_mov_b32 m0, %0" : "=&s"(keep) : "v"(gsrc), "s"(lds_dst) : "memory"); }
__device__ __forceinline__ void attn_unit(const Args& a, int bh, int qb, int half, LAS unsigned char* lds) {
    const int tid = tid_fresh(), lane = tid & 63, wave = __builtin_amdgcn_readfirstlane(tid >> 6), r = lane & 15, q4 = lane >> 4;
    const int qrow0 = half * 128 + wave * 16;
    const bf16_t* Qg = (const bf16_t*)(a.ws + WS_Q) + ((size_t)bh * SEQ + qb * MBLK + qrow0) * HD;
    const bf16_t* Kg = (const bf16_t*)(a.ws + WS_K) + (size_t)bh * SEQ * HD;
    const bf16_t* Vg = (const bf16_t*)(a.ws + WS_VT) + (size_t)bh * SEQ * HD;
    const float* KM = (const float*)(a.ws + WS_KMEAN) + (size_t)bh * NBLK * HD;
    LAS float* kml = (LAS float*)(lds + AT_KM);
    asm volatile("s_waitcnt vmcnt(0)" ::: "memory");
    for (int i = tid; i < qb * HD; i += NTHR) kml[i] = KM[i];
    bf16x8 Qf[4];
#pragma unroll
    for (int kk = 0; kk < 4; ++kk) Qf[kk] = __builtin_nontemporal_load((const bf16x8*)(Qg + (size_t)r * HD + 32 * kk + 8 * q4));
    const int nown = half ? 4 : 2, NT = nown + 4 * qb;
    unsigned koff[2], voff[2];
#pragma unroll
    for (int i = 0; i < 2; ++i) { const int row = 4 * (2 * wave + i) + (lane >> 4), pc = lane & 15;
        koff[i] = (unsigned)(row * HD + ((pc ^ (row & 15)) * 8)) * 2u;
        voff[i] = (unsigned)(row * HD + ((pc ^ (((row & 3) << 2) | ((row >> 2) & 3))) * 8)) * 2u; }
#define AT_ISSUE(t) do { const int own_ = (t) < nown; const int blk_ = own_ ? qb : (((t) - nown) >> 2), T_ = own_ ? (t) : (((t) - nown) & 3); const size_t gb_ = (size_t)(blk_ * MBLK + 64 * T_) * HD * 2; \
        const unsigned sl_ = (unsigned)__builtin_amdgcn_readfirstlane((int)(lds0 + ((t) & 3) * AT_SLOT + wave * 2048)); \
        _Pragma("unroll") for (int i_ = 0; i_ < 2; ++i_) { \
            glds16((const char*)Kg + gb_ + koff[i_], sl_ + i_ * 1024); \
            glds16((const char*)Vg + gb_ + voff[i_], sl_ + 16384 + i_ * 1024); } } while (0)
    const unsigned lds0 = (unsigned)(size_t)lds;
    AT_ISSUE(0); if (NT > 1) AT_ISSUE(1); if (NT > 2) AT_ISSUE(2);
    __syncthreads();
    unsigned sel;
    {
        float gate[7];
#pragma unroll
        for (int j = 0; j < 7; ++j) {
            float gsum = -INFINITY;
            if (j < qb) { float s = 0.f;
#pragma unroll
                for (int kk = 0; kk < 4; ++kk) { const f32x4 k0 = *(const LAS f32x4*)(kml + j * HD + 32 * kk + 8 * q4), k1 = *(const LAS f32x4*)(kml + j * HD + 32 * kk + 8 * q4 + 4);
                    const bf16x8 qv = Qf[kk];
                    s += bf2f((unsigned short)qv[0]) * k0[0] + bf2f((unsigned short)qv[1]) * k0[1] + bf2f((unsigned short)qv[2]) * k0[2] + bf2f((unsigned short)qv[3]) * k0[3]
                       + bf2f((unsigned short)qv[4]) * k1[0] + bf2f((unsigned short)qv[5]) * k1[1] + bf2f((unsigned short)qv[6]) * k1[2] + bf2f((unsigned short)qv[7]) * k1[3]; }
                s += swz_xor<16>(s); s = add_x32(s, lane); gsum = s; }
            gate[j] = gsum;
        }
        unsigned m = 0u;
#pragma unroll
        for (int j = 0; j < 7; ++j) { int cnt = 0;
#pragma unroll
            for (int i = 0; i < 7; ++i) if (i != j) cnt += (gate[i] > gate[j] || (gate[i] == gate[j] && i < j)) ? 1 : 0;
            if (cnt < 3) m |= 1u << j; }
        sel = m & ((1u << qb) - 1u);
    }
    f32x4 o[8];
#pragma unroll
    for (int dt = 0; dt < 8; ++dt) o[dt] = (f32x4){0.f, 0.f, 0.f, 0.f};
    float mref = -INFINITY, lrun = 0.f;
    constexpr float SC = 0.08838834764831845f * 1.4426950408889634f;
    constexpr float THR = 8.0f;
    const int qi = qrow0 + r;
    const int pir = 8 * ((r >> 2) & 1) + 4 * (r >> 3) + (r & 3);
    const int kbase_g = 8 * (q4 & 1) + 4 * (q4 >> 1);
    int kaddr[4];
#pragma unroll
    for (int kk = 0; kk < 4; ++kk) kaddr[kk] = pir * 256 + (((4 * kk + q4) ^ pir) * 16);
    const int fg = (2 * (q4 & 1) + (q4 >> 1)) & 3, vq = r >> 2, vp = r & 3;
    int vaddr[8];
#pragma unroll
    for (int dt = 0; dt < 8; ++dt) vaddr[dt] = 16384 + (kbase_g + vq) * 256 + (((2 * dt + (vp >> 1)) ^ ((vq << 2) | fg)) * 16) + 8 * (vp & 1);
    if (wave >= 4) __builtin_amdgcn_s_setprio(1);
    for (int t = 0; t < NT; ++t) {
        if (t + 2 < NT) asm volatile("s_waitcnt vmcnt(8)" ::: "memory"); else if (t + 1 < NT) asm volatile("s_waitcnt vmcnt(4)" ::: "memory"); else asm volatile("s_waitcnt vmcnt(0)" ::: "memory");
        __builtin_amdgcn_s_barrier(); asm volatile("" ::: "memory");
        if (t + 3 < NT) AT_ISSUE(t + 3);
        const bool own = t < nown; const int blk = own ? qb : ((t - nown) >> 2), T = own ? t : ((t - nown) & 3);
        const bool lsel = own ? true : ((sel >> blk) & 1u) != 0u;
        const bool active = own ? (64 * T <= qrow0 + 15) : (__any((int)lsel) != 0);
        if (active) {
            const LAS unsigned char* sl = lds + (t & 3) * AT_SLOT;
            f32x4 s[4];
            bf16x8 kf[4][4];
#pragma unroll
            for (int kk = 0; kk < 4; ++kk)
#pragma unroll
                for (int kt = 0; kt < 4; ++kt) kf[kk][kt] = *(const LAS bf16x8*)(sl + kaddr[kk] + kt * 4096);
            __builtin_amdgcn_sched_barrier(0);
#pragma unroll
            for (int kt = 0; kt < 4; ++kt) s[kt] = (f32x4){0.f, 0.f, 0.f, 0.f};
#pragma unroll
            for (int kk = 0; kk < 4; ++kk)
#pragma unroll
                for (int kt = 0; kt < 4; ++kt) s[kt] = __builtin_amdgcn_mfma_f32_16x16x32_bf16(kf[kk][kt], Qf[kk], s[kt], 0, 0, 0);
            v4i16_t vlo[2][8], vhi[2][8];
#pragma unroll
            for (int dt = 0; dt < 8; ++dt) { vlo[0][dt] = __builtin_amdgcn_ds_read_tr16_b64_v4i16((LAS v4i16_t*)(sl + vaddr[dt])); vhi[0][dt] = __builtin_amdgcn_ds_read_tr16_b64_v4i16((LAS v4i16_t*)(sl + vaddr[dt] + 4096)); }
            __builtin_amdgcn_sched_barrier(0);
            if (own && 64 * T + 63 > qrow0) {
#pragma unroll
                for (int kt = 0; kt < 4; ++kt)
#pragma unroll
                    for (int j = 0; j < 4; ++j) if (64 * T + 16 * kt + kbase_g + j > qi) s[kt][j] = -INFINITY; }
            float mx = max3f(s[0][0], s[0][1], s[0][2]);
            mx = max3f(mx, s[0][3], s[1][0]); mx = max3f(mx, s[1][1], s[1][2]); mx = max3f(mx, s[1][3], s[2][0]); mx = max3f(mx, s[2][1], s[2][2]);
            mx = max3f(mx, s[2][3], s[3][0]); mx = max3f(mx, s[3][1], s[3][2]); mx = fmaxf(mx, s[3][3]);
            mx = lsel ? mx : -INFINITY;
            mx = fmaxf(mx, swz_xor<16>(mx)); mx = max_x32(mx, lane);
            mx *= SC;
            if (__any((int)(mx > mref + THR))) {
                const float mnew = fmaxf(mref, mx); const float alpha = __builtin_amdgcn_exp2f(mref - mnew);
                mref = mnew; lrun *= alpha;
#pragma unroll
                for (int dt = 0; dt < 8; ++dt) o[dt] *= alpha;
            }
            const float negm = lsel ? -mref : -INFINITY;
            const f32x2 negm2 = {negm, negm}, sc2 = {SC, SC};
            f32x2 ps2 = {0.f, 0.f};
            unsigned pw[8];
#pragma unroll
            for (int kt = 0; kt < 4; ++kt)
#pragma unroll
                for (int h = 0; h < 2; ++h) { f32x2 v = {s[kt][2 * h], s[kt][2 * h + 1]}; v = v * sc2 + negm2;
                    f32x2 p; p.x = __builtin_amdgcn_exp2f(v.x); p.y = __builtin_amdgcn_exp2f(v.y); ps2 += p; pw[2 * kt + h] = pk2(p.x, p.y); }
            lrun += ps2.x + ps2.y;
            bf16x8 P[2];
#pragma unroll
            for (int c = 0; c < 2; ++c) { u32x4 w; w.x = pw[4 * c]; w.y = pw[4 * c + 1]; w.z = pw[4 * c + 2]; w.w = pw[4 * c + 3]; P[c] = __builtin_bit_cast(bf16x8, w); }
            __builtin_amdgcn_sched_barrier(0);
#pragma unroll
            for (int dt = 0; dt < 8; ++dt) { vlo[1][dt] = __builtin_amdgcn_ds_read_tr16_b64_v4i16((LAS v4i16_t*)(sl + vaddr[dt] + 8192)); vhi[1][dt] = __builtin_amdgcn_ds_read_tr16_b64_v4i16((LAS v4i16_t*)(sl + vaddr[dt] + 8192 + 4096)); }
            __builtin_amdgcn_sched_barrier(0);
#pragma unroll
            for (int c = 0; c < 2; ++c) {
#pragma unroll
                for (int dt = 0; dt < 8; ++dt) { const v4i16_t lo = vlo[c][dt], hi = vhi[c][dt];
                    const bf16x8 vf = (bf16x8){lo[0], lo[1], lo[2], lo[3], hi[0], hi[1], hi[2], hi[3]};
                    o[dt] = __builtin_amdgcn_mfma_f32_16x16x32_bf16(vf, P[c], o[dt], 0, 0, 0); }
                __builtin_amdgcn_sched_barrier(0);
            }
        }
    }
    __builtin_amdgcn_s_setprio(0);
    asm volatile("s_waitcnt lgkmcnt(0)" ::: "memory");
    __builtin_amdgcn_s_barrier(); asm volatile("" ::: "memory");
#undef AT_ISSUE
    const int b = bh >> 3, h = bh & 7;
    float l = lrun; l += swz_xor<16>(l); l = add_x32(l, lane);
    const float il = 1.0f / l;
    bf16_t* op = (bf16_t*)(a.ws + WS_OC) + ((size_t)b * SEQ + qb * MBLK + qi) * DM + h * HD + 4 * q4;
#pragma unroll
    for (int dt = 0; dt < 8; ++dt) { const f32x4 v = o[dt] * il; u32x2 w; w.x = pk2(v[0], v[1]); w.y = pk2(v[2], v[3]); *(u32x2*)(op + 16 * dt) = w; }
}

#define XB_TMO      128
#define XB_XCNT(j)  (256  + 64 * (j))
#define XB_XSUB(j)  (1280 + 64 * (j))
#define XB_XGEN(j)  (2304 + 64 * (j))
#define XB_TOP      3328
#define XB_TOPGEN   3392
#define XCD_BAR_WORDS 3456
#define XB_SPIN_CAP (1u << 18)
__device__ __forceinline__ unsigned xb_ld(unsigned* p)              { return __hip_atomic_load(p, __ATOMIC_RELAXED, __HIP_MEMORY_SCOPE_AGENT); }
__device__ __forceinline__ unsigned xb_add(unsigned* p, unsigned v) { return __hip_atomic_fetch_add(p, v, __ATOMIC_RELAXED, __HIP_MEMORY_SCOPE_AGENT); }
__device__ __forceinline__ unsigned xb_xcc_id() { return (unsigned)__builtin_amdgcn_s_getreg((3 << 11) | 20) & 0xFu; }
#define XB_SPIN(cond, bar) do { unsigned _sp = 0; while (cond) { __builtin_amdgcn_s_sleep(1); \
    if ((++_sp & 255u) == 0u) { if (xb_ld(&(bar)[XB_TMO])) break; if (_sp > XB_SPIN_CAP) { atomicAdd(&(bar)[XB_TMO], 1u); break; } } } } while (0)
struct XcdBarrier { unsigned* bar; unsigned x; volatile LAS unsigned* st; };
__device__ __forceinline__ XcdBarrier xcd_barrier_post(unsigned* bar, volatile LAS unsigned* st) {
    XcdBarrier b; b.bar = bar; b.x = xb_xcc_id(); b.st = st;
    if (threadIdx.x == 0) (void)xb_add(&bar[XB_XCNT(b.x)], 1u);
    return b;
}
__device__ __forceinline__ void xcd_barrier_complete(unsigned* bar, unsigned x, unsigned& nloc, unsigned& nx) {
    const unsigned G = gridDim.x * gridDim.y * gridDim.z;
    unsigned sum, cnt, mine, sp = 0u;
    for (;;) {
        sum = 0u; cnt = 0u; mine = 0u;
#pragma unroll
        for (unsigned j = 0; j < 16; ++j) { const unsigned c = xb_ld(&bar[XB_XCNT(j)]); sum += c; cnt += (c > 0u) ? 1u : 0u; mine = (j == x) ? c : mine; }
        if (sum == G) break;
        __builtin_amdgcn_s_sleep(1);
        if ((++sp & 255u) == 0u) { if (xb_ld(&bar[XB_TMO])) break; if (sp > XB_SPIN_CAP) { atomicAdd(&bar[XB_TMO], 1u); break; } }
    }
    nloc = mine > 0u ? mine : 1u; nx = cnt > 0u ? cnt : 1u;
}
__device__ __forceinline__ void xcd_barrier(const XcdBarrier& b) {
    asm volatile("s_waitcnt vmcnt(0)" ::: "memory");
    __syncthreads();
    if (threadIdx.x == 0) {
        unsigned* bar = b.bar;
        const unsigned bx_ = xb_xcc_id();
        __builtin_amdgcn_s_waitcnt(0);
        unsigned nloc = b.st[0], nx = b.st[1];
        if (nloc == 0u) { xcd_barrier_complete(bar, bx_, nloc, nx); b.st[0] = nloc; b.st[1] = nx; }
        const unsigned old = xb_add(&bar[XB_XSUB(bx_)], 1u);
        const unsigned gen = old / nloc;
        if (old + 1u == (gen + 1u) * nloc) {
            __builtin_amdgcn_fence(__ATOMIC_RELEASE, "agent");
            asm volatile("s_waitcnt vmcnt(0)" ::: "memory");
            const unsigned og = xb_add(&bar[XB_TOP], 1u);
            const unsigned tg = og / nx;
            if (og + 1u == (tg + 1u) * nx) {
#pragma unroll
                for (unsigned j = 0; j < 16; ++j) (void)xb_add(&bar[XB_XGEN(j)], 1u);
            } else XB_SPIN(xb_ld(&bar[XB_XGEN(bx_)]) == gen, bar);
            __builtin_amdgcn_fence(__ATOMIC_ACQUIRE, "agent");
            asm volatile("s_waitcnt vmcnt(0)" ::: "memory");
        } else {
            XB_SPIN(xb_ld(&bar[XB_XGEN(bx_)]) == gen, bar);
            __builtin_amdgcn_fence(__ATOMIC_ACQUIRE, "agent");
            asm volatile("s_waitcnt vmcnt(0)" ::: "memory");
        }
    }
    __syncthreads();
}

__global__ void __launch_bounds__(NTHR, 2) hymba_fwd(Args a) {
    extern __shared__ __attribute__((aligned(16))) unsigned char lds_raw[];
    LAS unsigned char* lds = (LAS unsigned char*)lds_raw;
    LAS float* ldsf = (LAS float*)lds_raw;
    cg::grid_group grid = cg::this_grid();
    const int G = gridDim.x, bx = blockIdx.x;
    unsigned char* ws = a.ws;
    volatile LAS unsigned* bst = (volatile LAS unsigned*)(lds + LDS_BYTES - 64);
    volatile LAS unsigned long long* stash = (volatile LAS unsigned long long*)(lds + LDS_BYTES - 128);
    if (threadIdx.x < 2) bst[threadIdx.x] = 0u;
    if (threadIdx.x == 0) { stash[0] = (unsigned long long)a.pool_scale; stash[1] = (unsigned long long)a.x; stash[2] = (unsigned long long)a.out; stash[3] = (unsigned long long)a.g_ffn; stash[4] = (unsigned long long)a.w_down; stash[5] = (unsigned long long)a.w_gate; stash[6] = (unsigned long long)a.w_up; }
    __syncthreads();
#define STASHED(T, i) ((T)(((unsigned long long)(unsigned)__builtin_amdgcn_readfirstlane((int)(stash[i] & 0xffffffffull))) | ((unsigned long long)(unsigned)__builtin_amdgcn_readfirstlane((int)(stash[i] >> 32)) << 32)))
    const XcdBarrier bar = xcd_barrier_post((unsigned*)(ws + WS_CTL), bst);
#define GRID_BAR() xcd_barrier(bar)
#ifndef DUPMASK
#define DUPMASK 0
#endif
#define REP(k) for (int rep_ = 0; rep_ < (((DUPMASK) >> (k)) & 1 ? 2 : 1); ++rep_)

    if (a.ws == nullptr) grid.sync();
    { p0_ada(a, ldsf);
    if ((DUPMASK) & 256) { __syncthreads(); p0_ada(a, ldsf); }
    p0_convert<0>(a, lds, bx, G, nullptr);
    if ((DUPMASK) & 512) { __syncthreads(); p0_convert<0>(a, lds, bx, G, nullptr); }
    GRID_BAR(); }
    REP(1) { norm_phase<true>(a, a.x, a.g_mix, 0, 1, (bf16_t*)(ws + WS_XN), ldsf);
    GRID_BAR(); }
    REP(2) { pg8::Gemm g{(const bf16_t*)(ws + WS_XN), (const bf16_t*)(ws + WS_WIN), MTOK, INW, DM, DM, DM}; pg8::StaticOrder S; S.init(MTOK, INW, G, bx);
      pg8::EpiF32 E{(bf16_t*)(ws + WS_ZF), INW, (bf16_t*)(ws + WS_VT), (bf16_t*)(ws + WS_Q), (bf16_t*)(ws + WS_K), (float*)(ws + WS_KMEAN), a.g_q, a.g_k, (const float*)(ws + WS_COS), (const float*)(ws + WS_SIN), (LAS float*)(lds + 131072)};
      pg8::gemm_phase<pg8::EpiF32, pg8::StaticOrder, true>(lds, g, S, E);
    GRID_BAR(); }
    REP(4) {
    const bool gu_early = ((bx >> 3) & 1) == 0;
    if (rep_ == 0 && gu_early) { p0_convert<2>(a, lds, bx, G, STASHED(const float*, 5), STASHED(const float*, 6)); __syncthreads(); }
    for (int u = bx; u < 256; u += G) {
        const int x = u & 7, i = u >> 3, s2 = i >> 4, j = i & 15, qb = j >> 1, hf = j & 1;
        attn_unit(a, x + 8 * s2, qb, hf, lds); __syncthreads();
        attn_unit(a, x + 16 + 8 * s2, 7 - qb, 1 - hf, lds); __syncthreads(); }
    if (rep_ == 0 && !gu_early) { p0_convert<2>(a, lds, bx, G, STASHED(const float*, 5), STASHED(const float*, 6)); __syncthreads(); }
    for (int w = G - 1 - bx; w < 128; w += G) {
        const int grp = w >> 5, pm = w & 31;
        p3_unit(a, pm, 24 + 2 * grp, ldsf); p3_unit(a, pm, 25 + 2 * grp, ldsf);
        asm volatile("s_waitcnt vmcnt(0)" ::: "memory"); __syncthreads();
        pg8::Gemm g{(const bf16_t*)(ws + WS_PB) + grp * 256, (const bf16_t*)(ws + WS_WPOOL) + (size_t)grp * 65536, MTOK, 256, 256, PW, 256};
        pg8::OneUnit S{pm, 0, 1};
        pg8::EpiScaleBf16 E{(bf16_t*)(ws + WS_OC) + AW + grp * 256, DM, STASHED(const float*, 0) + grp * 256};
        pg8::gemm_phase<pg8::EpiScaleBf16, pg8::OneUnit, true>(lds, g, S, E);
    }
    if (rep_ == 0) { const float* wd = STASHED(const float*, 4);
        const int w = G - 1 - bx;
        if (G > 128) { if (w >= 128) p0_convert<1>(a, lds, w - 128, G - 128, wd); } else p0_convert<1>(a, lds, bx, G, wd); }
    GRID_BAR(); }
    if (G == 256) {
      REP(5) { pg8::Gemm g{(const bf16_t*)(ws + WS_OC), (const bf16_t*)(ws + WS_WOUT), MTOK, DM, DM, DM, DM}; pg8::StaticOrder S; S.init(MTOK, DM, G, bx);
      const float* mod = (const float*)(ws + WS_MOD);
      pg8::EpiGateResNorm E{STASHED(const float*, 1), STASHED(float*, 2), DM, mod + 2 * DM, STASHED(const float*, 3), mod + 4 * DM, mod + 3 * DM, MODW, (bf16_t*)(ws + WS_XN), (float*)(ws + WS_SLOTS), (unsigned*)(ws + WS_CTL) + CW_PANEL + rep_ * 2048};
      pg8::gemm_phase<pg8::EpiGateResNorm, pg8::StaticOrder, true>(lds, g, S, E);
      GRID_BAR(); }
    } else {
      { pg8::Gemm g{(const bf16_t*)(ws + WS_OC), (const bf16_t*)(ws + WS_WOUT), MTOK, DM, DM, DM, DM}; pg8::StaticOrder S; S.init(MTOK, DM, G, bx);
      pg8::EpiGateRes E{STASHED(const float*, 1), STASHED(float*, 2), DM, (const float*)(ws + WS_MOD) + 2 * DM, MODW};
      pg8::gemm_phase<pg8::EpiGateRes, pg8::StaticOrder, true>(lds, g, S, E);
      GRID_BAR(); }
      norm_phase<false>(a, STASHED(const float*, 2), STASHED(const float*, 3), 3, 4, (bf16_t*)(ws + WS_XN), ldsf);
      GRID_BAR();
    }
    REP(7) { pg8::Gemm g{(const bf16_t*)(ws + WS_XN), (const bf16_t*)(ws + WS_WGU), MTOK, 2 * DFF, DM, DM, DM}; pg8::StaticOrder S; S.init(MTOK, 2 * DFF, G, bx);
      const bool tail = (G == 256);
      if (tail) S.lim = (S.nwg / G) * G;
      { pg8::EpiSwiGLU E{(bf16_t*)(ws + WS_ZF), DFF, -1};
        pg8::gemm_phase<pg8::EpiSwiGLU, pg8::StaticOrder, true>(lds, g, S, E); }
      if (tail) {
          pg8::Unit tu; const int hw = bx >> 7;
          const bool has = S.at(S.lim + (bx & 127), tu);
          pg8::OneUnit S1{tu.pm, tu.pn, has ? 1 : 0};
          pg8::EpiSwiGLU E{(bf16_t*)(ws + WS_ZF), DFF, hw};
          if (hw == 0) pg8::gemm_phase<pg8::EpiSwiGLU, pg8::OneUnit, true, 0>(lds, g, S1, E); else pg8::gemm_phase<pg8::EpiSwiGLU, pg8::OneUnit, true, 1>(lds, g, S1, E);
      }
    GRID_BAR(); }
    { pg8::Gemm g{(const bf16_t*)(ws + WS_ZF), (const bf16_t*)(ws + WS_WDN), MTOK, DM, DFF, DFF, DFF}; pg8::StaticOrder S; S.init(MTOK, DM, G, bx);
      float* outp = STASHED(float*, 2);
      pg8::EpiGateRes E{outp, outp, DM, (const float*)(ws + WS_MOD) + 5 * DM, MODW};
      pg8::gemm_phase<pg8::EpiGateRes, pg8::StaticOrder, true>(lds, g, S, E); }
}

extern "C" void kernel_launch(void* const* d_in, const int* in_sizes, int n_in, void* d_out, int out_size, void* d_ws, size_t ws_size, hipStream_t stream) {
    static int grid = 0;
    if (grid == 0) {
        if (n_in != 16 || out_size != MTOK * DM || ws_size < WS_END) { fprintf(stderr, "kernel_launch: unexpected problem (n_in %d, out %d, ws %zu)\n", n_in, out_size, ws_size); grid = -1; return; }
        int dev = 0, cus = 0, per_cu = 0;
        hipGetDevice(&dev);
        hipDeviceGetAttribute(&cus, hipDeviceAttributeMultiprocessorCount, dev);
        if (hipFuncSetAttribute((const void*)hymba_fwd, hipFuncAttributeMaxDynamicSharedMemorySize, LDS_BYTES) != hipSuccess) { fprintf(stderr, "kernel_launch: hipFuncSetAttribute failed\n"); grid = -1; return; }
        if (hipOccupancyMaxActiveBlocksPerMultiprocessor(&per_cu, (const void*)hymba_fwd, NTHR, LDS_BYTES) != hipSuccess || per_cu < 1) { fprintf(stderr, "kernel_launch: occupancy query gave %d\n", per_cu); per_cu = 1; }
        (void)hipGetLastError();
        grid = cus * per_cu;
    }
    if (grid < 0) return;
    Args a{};
    a.x = (const float*)d_in[0]; a.c = (const float*)d_in[1]; a.pos = (const int*)d_in[2]; a.w_ada = (const float*)d_in[3]; a.b_ada = (const float*)d_in[4];
    a.g_mix = (const float*)d_in[5]; a.w_in = (const float*)d_in[6]; a.g_q = (const float*)d_in[7]; a.g_k = (const float*)d_in[8]; a.w_pool = (const float*)d_in[9];
    a.pool_scale = (const float*)d_in[10]; a.w_out = (const float*)d_in[11]; a.g_ffn = (const float*)d_in[12]; a.w_gate = (const float*)d_in[13]; a.w_up = (const float*)d_in[14];
    a.w_down = (const float*)d_in[15]; a.out = (float*)d_out; a.ws = (unsigned char*)d_ws;
    if (hipMemsetAsync((char*)d_ws + WS_CTL, 0, CTL_ZERO_BYTES, stream) != hipSuccess) { fprintf(stderr, "kernel_launch: memset of control words failed\n"); return; }
    void* args[] = {&a};
    hipError_t e = hipLaunchCooperativeKernel((const void*)hymba_fwd, dim3(grid), dim3(NTHR), args, LDS_BYTES, stream);
    if (e != hipSuccess) fprintf(stderr, "kernel_launch: cooperative launch failed: %s (grid %d)\n", hipGetErrorString(e), grid);
}
```
